# Optimizing an MI355X kernel written in HIP

```python
import math
import jax, jax.numpy as jnp
from jax import lax
import numpy as np

D_MODEL = 1024
BATCH = 32
SEQ = 2048
DEPTH = 2
DEC_BATCH = 32
DEC_SEQ = 16
PAST_LEN = 1024

CHUNK = 64
N_HEADS = 8
HEAD_DIM = 64
ATTN_WIDTH = N_HEADS * HEAD_DIM
LRU_WIDTH = D_MODEL - ATTN_WIDTH
LRU_BLOCKS = 8
LRU_BLOCK_DIM = LRU_WIDTH // LRU_BLOCKS
CONV_W = 4
RGLRU_C = 8.0
D_FF = 4 * D_MODEL
Q_BLOCK = 128
EPS = 1e-6
ATTN_SCALE = 1.0 / math.sqrt(HEAD_DIM)
SPLITS = (ATTN_WIDTH, 2 * ATTN_WIDTH, 3 * ATTN_WIDTH, 3 * ATTN_WIDTH + N_HEADS,
          3 * ATTN_WIDTH + N_HEADS + LRU_WIDTH)
IN_WIDTH = 3 * ATTN_WIDTH + N_HEADS + 2 * LRU_WIDTH

kernel_name = "hymba_fox_rglru_streaming_step"


def rms_norm(x, g):
    xf = x.astype(jnp.float32)
    y = xf * lax.rsqrt(jnp.mean(xf * xf, axis=-1, keepdims=True) + EPS)
    return (y * g).astype(x.dtype)


def fox_attend(q, k, v, cq, ck, q_pos, k_pos):
    s = jnp.einsum('bqhd,bkhd->bhqk', q, k, preferred_element_type=jnp.float32) * ATTN_SCALE
    s = s + jnp.transpose(cq, (0, 2, 1))[:, :, :, None] - jnp.transpose(ck, (0, 2, 1))[:, :, None, :]
    mask = k_pos[None, :] <= q_pos[:, None]
    s = jnp.where(mask[None, None], s, -jnp.inf)
    p = jax.nn.softmax(s, axis=-1).astype(v.dtype)
    return jnp.einsum('bhqk,bkhd->bqhd', p, v)


def fox_prompt(q, k, v, logf):
    B, T, H, Dh = q.shape
    c = jnp.cumsum(logf, axis=1)
    nb = T // Q_BLOCK
    qb = jnp.transpose(q.reshape(B, nb, Q_BLOCK, H, Dh), (1, 0, 2, 3, 4))
    cqb = jnp.transpose(c.reshape(B, nb, Q_BLOCK, H), (1, 0, 2, 3))
    posb = jnp.arange(T, dtype=jnp.int32).reshape(nb, Q_BLOCK)
    kpos = jnp.arange(T, dtype=jnp.int32)

    def one_block(args):
        qi, cqi, pi = args
        return fox_attend(qi, k, v, cqi, c, pi, kpos)

    out = lax.map(one_block, (qb, cqb, posb))
    return jnp.transpose(out, (1, 0, 2, 3, 4)).reshape(B, T, H, Dh)


def fox_sample(q, k, v, logf, k_past, v_past, logf_past):
    P = k_past.shape[1]
    T = q.shape[1]
    k_all = jnp.concatenate([k_past.astype(k.dtype), k], axis=1)
    v_all = jnp.concatenate([v_past.astype(v.dtype), v], axis=1)
    c_all = jnp.cumsum(jnp.concatenate([logf_past.astype(jnp.float32), logf], axis=1), axis=1)
    q_pos = P + jnp.arange(T, dtype=jnp.int32)
    k_pos = jnp.arange(P + T, dtype=jnp.int32)
    return fox_attend(q, k_all, v_all, c_all[:, P:], c_all, q_pos, k_pos)


def causal_conv(x, buf, w, b):
    T = x.shape[1]
    xp = jnp.concatenate([buf.astype(x.dtype), x], axis=1)
    y = sum(xp[:, j:j + T] * w[j] for j in range(CONV_W)) + b
    return y.astype(x.dtype), xp[:, -(CONV_W - 1):]


def rg_lru(x, h0, w_ga, b_ga, w_gx, b_gx, lam):
    B, T, W = x.shape
    xb = x.reshape(B, T, LRU_BLOCKS, LRU_BLOCK_DIM)
    r = jax.nn.sigmoid((jnp.einsum('btnc,ncd->btnd', xb, w_ga).reshape(B, T, W) + b_ga).astype(jnp.float32))
    i = jax.nn.sigmoid((jnp.einsum('btnc,ncd->btnd', xb, w_gx).reshape(B, T, W) + b_gx).astype(jnp.float32))
    log_a = -RGLRU_C * r * jax.nn.softplus(-lam.astype(jnp.float32))
    a = jnp.exp(log_a)
    bterm = jnp.sqrt(-jnp.expm1(2.0 * log_a)) * (i * x.astype(jnp.float32))
    bterm = bterm.at[:, 0].add(a[:, 0] * h0.astype(jnp.float32))

    def combine(left, right):
        a1, b1 = left
        a2, b2 = right
        return a1 * a2, a2 * b1 + b2

    _, h = lax.associative_scan(combine, (a, bterm), axis=1)
    return h, h[:, -1]


def hybrid_layer(x, past, ln1, w_in, b_f, q_gain, k_gain, conv_w, conv_b, w_ga, b_ga,
                 w_gx, b_gx, lam, g_ao, g_lo, w_out, ln2, w_up, w_down):
    B, T, _ = x.shape
    h = rms_norm(x, ln1)
    proj = h @ w_in
    q, k, v, f, xr, yg = jnp.split(proj, SPLITS, axis=-1)
    q = rms_norm(q.reshape(B, T, N_HEADS, HEAD_DIM), q_gain)
    k = rms_norm(k.reshape(B, T, N_HEADS, HEAD_DIM), k_gain)
    v = v.reshape(B, T, N_HEADS, HEAD_DIM)
    logf = jax.nn.log_sigmoid((f + b_f).astype(jnp.float32))

    if past is None:
        attn = fox_prompt(q, k, v, logf)
        h0 = jnp.zeros((B, LRU_WIDTH), jnp.float32)
        conv_buf = jnp.zeros((B, CONV_W - 1, LRU_WIDTH), x.dtype)
    else:
        k_past, v_past, logf_past, h0, conv_buf = past
        attn = fox_sample(q, k, v, logf, k_past, v_past, logf_past)

    xc, new_conv = causal_conv(xr, conv_buf, conv_w, conv_b)
    hs, h_last = rg_lru(xc, h0, w_ga, b_ga, w_gx, b_gx, lam)
    lru_out = jax.nn.gelu(yg) * hs.astype(x.dtype)

    mixed = jnp.concatenate([rms_norm(attn.reshape(B, T, ATTN_WIDTH), g_ao),
                             rms_norm(lru_out, g_lo)], axis=-1)
    x = x + mixed @ w_out
    h2 = rms_norm(x, ln2)
    x = x + jnp.square(jax.nn.relu(h2 @ w_up)) @ w_down
    return x, (k, v, logf, h_last, new_conv)


def setup_inputs(seed: int = 0) -> dict:
    key = jax.random.key(seed)
    ks = jax.random.split(key, 32)
    f32 = jnp.float32
    nrm = lambda k, shape, s: jax.random.normal(k, shape, f32) * s
    u = jax.random.uniform(ks[14], (DEPTH, LRU_WIDTH), f32, 0.9, 0.999)
    return {
        "x_prompt": nrm(ks[0], (BATCH, SEQ, D_MODEL), 1.0),
        "x_sample": nrm(ks[1], (DEC_BATCH, DEC_SEQ, D_MODEL), 1.0),
        "cache_k": nrm(ks[2], (DEPTH, DEC_BATCH, PAST_LEN, N_HEADS, HEAD_DIM), 1.0),
        "cache_v": nrm(ks[3], (DEPTH, DEC_BATCH, PAST_LEN, N_HEADS, HEAD_DIM), 1.0),
        "cache_logf": jax.nn.log_sigmoid(3.0 + nrm(ks[4], (DEPTH, DEC_BATCH, PAST_LEN, N_HEADS), 1.0)),
        "state_h": nrm(ks[5], (DEPTH, DEC_BATCH, LRU_WIDTH), 0.5),
        "state_conv": nrm(ks[6], (DEPTH, DEC_BATCH, CONV_W - 1, LRU_WIDTH), 1.0),
        "ln1": 1.0 + nrm(ks[7], (DEPTH, D_MODEL), 0.02),
        "w_in": nrm(ks[8], (DEPTH, D_MODEL, IN_WIDTH), D_MODEL ** -0.5),
        "b_f": 3.0 + nrm(ks[9], (DEPTH, N_HEADS), 0.5),
        "q_gain": 1.0 + nrm(ks[10], (DEPTH, HEAD_DIM), 0.02),
        "k_gain": 1.0 + nrm(ks[11], (DEPTH, HEAD_DIM), 0.02),
        "conv_w": nrm(ks[12], (DEPTH, CONV_W, LRU_WIDTH), CONV_W ** -0.5),
        "conv_b": nrm(ks[13], (DEPTH, LRU_WIDTH), 0.02),
        "w_gate_a": nrm(ks[15], (DEPTH, LRU_BLOCKS, LRU_BLOCK_DIM, LRU_BLOCK_DIM), LRU_BLOCK_DIM ** -0.5),
        "b_gate_a": nrm(ks[16], (DEPTH, LRU_WIDTH), 0.1),
        "w_gate_x": nrm(ks[17], (DEPTH, LRU_BLOCKS, LRU_BLOCK_DIM, LRU_BLOCK_DIM), LRU_BLOCK_DIM ** -0.5),
        "b_gate_x": nrm(ks[18], (DEPTH, LRU_WIDTH), 0.1),
        "lru_lambda": jnp.log(u) - jnp.log1p(-u),
        "g_attn_out": 1.0 + nrm(ks[19], (DEPTH, ATTN_WIDTH), 0.02),
        "g_lru_out": 1.0 + nrm(ks[20], (DEPTH, LRU_WIDTH), 0.02),
        "w_out": nrm(ks[21], (DEPTH, D_MODEL, D_MODEL), D_MODEL ** -0.5),
        "ln2": 1.0 + nrm(ks[22], (DEPTH, D_MODEL), 0.02),
        "w_up": nrm(ks[23], (DEPTH, D_MODEL, D_FF), D_MODEL ** -0.5),
        "w_down": nrm(ks[24], (DEPTH, D_FF, D_MODEL), D_FF ** -0.5),
    }


def reference(x_prompt, x_sample, cache_k, cache_v, cache_logf, state_h, state_conv,
              ln1, w_in, b_f, q_gain, k_gain, conv_w, conv_b, w_gate_a, b_gate_a,
              w_gate_x, b_gate_x, lru_lambda, g_attn_out, g_lru_out, w_out, ln2, w_up, w_down):
    yp, ys = x_prompt, x_sample
    kp, vp, fp, hp, cp = [], [], [], [], []
    kss, vss, fss, hss, css = [], [], [], [], []
    for l in range(DEPTH):
        params = (ln1[l], w_in[l], b_f[l], q_gain[l], k_gain[l], conv_w[l], conv_b[l],
                  w_gate_a[l], b_gate_a[l], w_gate_x[l], b_gate_x[l], lru_lambda[l],
                  g_attn_out[l], g_lru_out[l], w_out[l], ln2[l], w_up[l], w_down[l])
        yp, (k1, v1, f1, h1, c1) = hybrid_layer(yp, None, *params)
        ys, (k2, v2, f2, h2, c2) = hybrid_layer(
            ys, (cache_k[l], cache_v[l], cache_logf[l], state_h[l], state_conv[l]), *params)
        kp.append(k1); vp.append(v1); fp.append(f1); hp.append(h1); cp.append(c1)
        kss.append(k2); vss.append(v2); fss.append(f2); hss.append(h2); css.append(c2)
    return (yp, ys,
            jnp.stack(kp), jnp.stack(vp), jnp.stack(fp), jnp.stack(hp), jnp.stack(cp),
            jnp.stack(kss), jnp.stack(vss), jnp.stack(fss), jnp.stack(hss), jnp.stack(css))
```

```cpp
#include <hip/hip_runtime.h>
#include <hip/hip_cooperative_groups.h>
#include <hip/hip_bf16.h>
#include <cstdio>
#include <cstdint>
#include <cmath>
namespace cg = cooperative_groups;

constexpr int DM_ = 1024, NB_ = 32, T_ = 2048, DB_ = 32, DT_ = 16, PAST_ = 1024, NH_ = 8, HD_ = 64, AW_ = 512, LW_ = 512, FF_ = 4096, DEPTH_ = 2;
constexpr int MP_ = NB_ * T_;
constexpr int MS_ = DB_ * DT_;
constexpr int M_ = MP_ + MS_;
constexpr int NIN_ = 2816;
constexpr int INW_ = 2568;
constexpr float EPS_ = 1e-6f;
constexpr float LOG2E_ = 1.4426950408889634f;
constexpr float C2_ = 0.125f * 1.4426950408889634f;

namespace pg8 {
#define PG8_LAS __attribute__((address_space(3)))
typedef unsigned short bf16_t;
typedef short bf16x8 __attribute__((ext_vector_type(8)));
typedef float f32x4 __attribute__((ext_vector_type(4)));
typedef unsigned u32x4 __attribute__((ext_vector_type(4)));
constexpr int BM = 256, BK = 64, HALF = 128, HTB = HALF * BK * 2  , STAGE_BYTES = 8 * HTB, NXCD = 8, WGM = 8;

__host__ __device__ __forceinline__ int lds_byte(int r, int c) { const int st = (r >> 4) * 2 + (c >> 5), rr = r & 15, cc = c & 31, ob = rr * 64 + cc * 2; return st * 1024 + (ob ^ (((ob >> 9) & 1) << 5)); }
__host__ __device__ __forceinline__ void stage_rc(int b, int& R, int& C) { const int st = b / 1024, sb = b % 1024, swz = sb ^ (((sb >> 9) & 1) << 5); R = (st >> 1) * 16 + swz / 64; C = (st & 1) * 32 + (swz % 64) / 2; }
__host__ __device__ __forceinline__ int perm32(int rho) { const int n = rho >> 4, i = rho & 15; return 8 * (i >> 2) + 4 * n + (i & 3); }

struct Unit { int pm, pn; };
struct Gemm { const bf16_t* A; const bf16_t* Bt; int M, N, K; };

struct StaticOrder {
    int nM, nN, nwg, G, c;
    __host__ __device__ void init(int M, int N, int G_, int c_) { nM = M / BM; nN = N / BM; nwg = nM * nN; G = G_; c = c_; }
    __host__ __device__ bool next(int i, Unit& u) const {
        const long L = (long)i * G + c; if (L >= nwg) return false;
        int wgid = (int)L; { const int q = nwg / NXCD, r = nwg % NXCD, xcd = wgid % NXCD, off = wgid / NXCD; wgid = (xcd < r ? xcd * (q + 1) : r * (q + 1) + (xcd - r) * q) + off; }
        const int nig = WGM * nN, gid = wgid / nig, fm = gid * WGM, gsz = (nM - fm) < WGM ? (nM - fm) : WGM;
        u.pm = fm + ((wgid % nig) % gsz); u.pn = (wgid % nig) / gsz; return true;
    }
    __device__ __forceinline__ void a_ready(const Unit&) const {}
    __device__ __forceinline__ void done(const Unit&) const {}
};

__device__ __forceinline__ unsigned cvt_pk_bf16(float lo, float hi) { unsigned r; asm volatile("v_cvt_pk_bf16_f32 %0, %1, %2" : "=v"(r) : "v"(lo), "v"(hi)); return r; }

typedef float f32x2 __attribute__((ext_vector_type(2)));
__device__ __forceinline__ float gelu_tanh(float x) {
    const float u = 0.7978845608028654f * (x + 0.044715f * x * x * x);
    const float e = __builtin_amdgcn_exp2f(-2.0f * 1.4426950408889634f * u);
    return x * __builtin_amdgcn_rcpf(1.0f + e);
}
__device__ __forceinline__ float log_sigmoid_f(float z) { return fminf(z, 0.f) - log1pf(__expf(-fabsf(z))); }

struct EpiIn {
    static constexpr bool PERM = true, AFTER_DRAIN = false;
    bf16_t* act; float* out; size_t slot; int l; const float *ss, *qg, *kg, *bfp;
    __device__ __forceinline__ void operator()(const f32x4 (&acc)[2][2][4][2], const Unit& u, int wr, int wc, int fr, int fq) const {
        const int kind = u.pn >> 1;
        const bool samp = u.pm >= (65536 / 256);
        const int colb = (u.pn & 1) * 256 + 64 * wc + 8 * fq;
        f32x4 g[2][2];
#pragma unroll
        for (int bj = 0; bj < 2; ++bj)
#pragma unroll
            for (int n = 0; n < 2; ++n) {
                g[bj][n] = (f32x4){1.f, 1.f, 1.f, 1.f};
                if (kind == 0) g[bj][n] = *(const f32x4*)(qg + 32 * bj + 8 * fq + 4 * n) * (0.125f * 1.4426950408889634f);
                if (kind == 1) g[bj][n] = *(const f32x4*)(kg + 32 * bj + 8 * fq + 4 * n);
            }
#pragma unroll
        for (int ai = 0; ai < 2; ++ai)
#pragma unroll
            for (int m = 0; m < 4; ++m) {
                const int row = u.pm * BM + ai * HALF + wr * 64 + m * 16 + fr;
                const float rs = 1.0f / sqrtf(ss[row] * (1.0f / 1024.0f) + 1e-6f);
                f32x4 v[2][2];
#pragma unroll
                for (int bj = 0; bj < 2; ++bj)
#pragma unroll
                    for (int n = 0; n < 2; ++n) v[bj][n] = acc[ai][bj][m][n] * rs;
                if (kind <= 1) {
                    float s = 0.f;
#pragma unroll
                    for (int bj = 0; bj < 2; ++bj)
#pragma unroll
                        for (int n = 0; n < 2; ++n) { const f32x4 x = v[bj][n]; s += (x[0] * x[0] + x[1] * x[1]) + (x[2] * x[2] + x[3] * x[3]); }
                    s += __shfl_xor(s, 16); s += __shfl_xor(s, 32);
                    const float inv = 1.0f / sqrtf(s * (1.0f / 64.0f) + 1e-6f);
#pragma unroll
                    for (int bj = 0; bj < 2; ++bj)
#pragma unroll
                        for (int n = 0; n < 2; ++n) v[bj][n] = v[bj][n] * inv * g[bj][n];
                }
                if (kind == 5) {
                    if (wc == 0 && fq == 0) {
                        float* lf = out + (samp ? (size_t)204079104 + (size_t)l * 4096 + (size_t)(row - 65536) * 8 : (size_t)201850880 + (size_t)l * 524288 + (size_t)row * 8);
#pragma unroll
                        for (int n = 0; n < 2; ++n) { const f32x4 b = *(const f32x4*)(bfp + 4 * n); f32x4 o;
#pragma unroll
                            for (int j = 0; j < 4; ++j) o[j] = log_sigmoid_f(v[0][n][j] + b[j]);
                            *(f32x4*)(lf + 4 * n) = o; }
                    }
                } else {
                    if (kind == 4) {
#pragma unroll
                        for (int bj = 0; bj < 2; ++bj)
#pragma unroll
                            for (int n = 0; n < 2; ++n)
#pragma unroll
                                for (int j = 0; j < 4; ++j) v[bj][n][j] = gelu_tanh(v[bj][n][j]);
                    }
                    bf16_t* rowp = act + (size_t)kind * slot + (size_t)row * 512 + colb;
#pragma unroll
                    for (int bj = 0; bj < 2; ++bj) { u32x4 w; w.x = cvt_pk_bf16(v[bj][0][0], v[bj][0][1]); w.y = cvt_pk_bf16(v[bj][0][2], v[bj][0][3]); w.z = cvt_pk_bf16(v[bj][1][0], v[bj][1][1]); w.w = cvt_pk_bf16(v[bj][1][2], v[bj][1][3]);
                        *(u32x4*)(rowp + 32 * bj) = w; }
                    if (kind == 1 || kind == 2) {
                        const size_t ob = samp ? (size_t)203030528 + (size_t)(kind - 1) * 524288 + (size_t)l * 262144 + (size_t)(row - 65536) * 512
                                               : (size_t)67633152 + (size_t)(kind - 1) * 67108864 + (size_t)l * 33554432 + (size_t)row * 512;
                        float* op = out + ob + colb;
#pragma unroll
                        for (int bj = 0; bj < 2; ++bj)
#pragma unroll
                            for (int n = 0; n < 2; ++n) *(f32x4*)(op + 32 * bj + 4 * n) = v[bj][n];
                    }
                }
            }
    }
};

struct EpiRes {
    static constexpr bool PERM = true, AFTER_DRAIN = false;
    const float* xin_p; const float* xin_s; float* yout; bf16_t* xb; float* ssacc; int wb;
    __device__ __forceinline__ void operator()(const f32x4 (&acc)[2][2][4][2], const Unit& u, int wr, int wc, int fr, int fq) const {
        const bool samp = u.pm >= (65536 / 256);
        const int col0 = u.pn * BM + wc * 32 + 8 * fq;
#pragma unroll
        for (int ai = 0; ai < 2; ++ai)
#pragma unroll
            for (int m = 0; m < 4; ++m) {
                const int row = u.pm * BM + ai * HALF + wr * 64 + m * 16 + fr;
                const float* xr_ = samp ? xin_s + (size_t)(row - 65536) * 1024 : xin_p + (size_t)row * 1024;
                float* yr = yout + (size_t)row * 1024;
                float s = 0.f;
#pragma unroll
                for (int bj = 0; bj < 2; ++bj) {
                    f32x4 x0 = *(const f32x4*)(xr_ + col0 + bj * HALF) + acc[ai][bj][m][0];
                    f32x4 x1 = *(const f32x4*)(xr_ + col0 + bj * HALF + 4) + acc[ai][bj][m][1];
                    *(f32x4*)(yr + col0 + bj * HALF) = x0; *(f32x4*)(yr + col0 + bj * HALF + 4) = x1;
                    if (wb) {
                        s += (x0[0] * x0[0] + x0[1] * x0[1]) + (x0[2] * x0[2] + x0[3] * x0[3]) + (x1[0] * x1[0] + x1[1] * x1[1]) + (x1[2] * x1[2] + x1[3] * x1[3]);
                        u32x4 w; w.x = cvt_pk_bf16(x0[0], x0[1]); w.y = cvt_pk_bf16(x0[2], x0[3]); w.z = cvt_pk_bf16(x1[0], x1[1]); w.w = cvt_pk_bf16(x1[2], x1[3]);
                        *(u32x4*)(xb + (size_t)row * 1024 + col0 + bj * HALF) = w;
                    }
                }
                if (wb) { s += __shfl_xor(s, 16); s += __shfl_xor(s, 32); if (fq == 0) atomicAdd(ssacc + row, s); }
            }
    }
};

struct EpiUp {
    static constexpr bool PERM = true, AFTER_DRAIN = false;
    bf16_t* H; const float* ss;
    __device__ __forceinline__ void operator()(const f32x4 (&acc)[2][2][4][2], const Unit& u, int wr, int wc, int fr, int fq) const {
        const int col0 = u.pn * BM + wc * 32 + 8 * fq;
#pragma unroll
        for (int ai = 0; ai < 2; ++ai)
#pragma unroll
            for (int m = 0; m < 4; ++m) {
                const int row = u.pm * BM + ai * HALF + wr * 64 + m * 16 + fr;
                const float rs = 1.0f / sqrtf(ss[row] * (1.0f / 1024.0f) + 1e-6f);
                bf16_t* hr = H + (size_t)row * 4096 + col0;
#pragma unroll
                for (int bj = 0; bj < 2; ++bj) {
                    f32x4 x0 = acc[ai][bj][m][0] * rs, x1 = acc[ai][bj][m][1] * rs;
#pragma unroll
                    for (int j = 0; j < 4; ++j) { const float a = fmaxf(x0[j], 0.f), b = fmaxf(x1[j], 0.f); x0[j] = a * a; x1[j] = b * b; }
                    u32x4 w; w.x = cvt_pk_bf16(x0[0], x0[1]); w.y = cvt_pk_bf16(x0[2], x0[3]); w.z = cvt_pk_bf16(x1[0], x1[1]); w.w = cvt_pk_bf16(x1[2], x1[3]);
                    *(u32x4*)(hr + bj * HALF) = w;
                }
            }
    }
};

template <class Epi, class Sched, bool ALIGN_EPI = false, bool SP2 = false, bool HEADPERM = false>
__device__ __forceinline__ void gemm_phase(PG8_LAS unsigned char* lds, const Gemm g, const Sched& S, const Epi& E) {
    int tid_l = threadIdx.x; asm volatile("" : "+v"(tid_l)); const int tid = tid_l, wid = __builtin_amdgcn_readfirstlane(tid >> 6), lane = tid & 63, wr = wid >> 2, wc = wid & 3, fr = lane & 15, fq = lane >> 4;
    const int K = g.K, nt = K / BK;
    unsigned voffA[2], voffB[2];
#pragma unroll
    for (int i = 0; i < 2; ++i) { int R, C; stage_rc(tid * 16 + i * 8192, R, C); const int Rb0 = Epi::PERM ? ((R & ~31) + perm32(R & 31)) : R; const int Rb = HEADPERM ? (64 * (Rb0 >> 5) + (Rb0 & 31)) : Rb0;
        voffA[i] = (unsigned)(R * K + C) * 2u; voffB[i] = (unsigned)(Rb * K + C) * 2u; }
    const size_t kstep = (size_t)(BK * 2);
    const size_t hstep = (size_t)HALF * K * 2;
    const size_t tstep = 2 * hstep; const size_t hstepB = HEADPERM ? (size_t)32 * K * 2 : hstep;
    const unsigned ldsw = (unsigned)wid * 1024u;
    const int aoff = lds_byte(wr * 64 + fr, fq * 8), boff = lds_byte(wc * 32 + fr, fq * 8);
#define PG8_SA(b, h) (((b) * 2 + (h)) * HTB)
#define PG8_SB(b, h) ((4 + (b) * 2 + (h)) * HTB)
#define PG8_STAGE(bufoff, gbase, voff) do { _Pragma("unroll") for (int _i = 0; _i < 2; ++_i) \
        __builtin_amdgcn_global_load_lds((const unsigned*)((const char*)(gbase) + (voff)[_i]), (PG8_LAS unsigned*)(lds + (bufoff) + ldsw + _i * 8192), 16, 0, 0); } while (0)
#define PG8_LDA(dst, b, h) do { _Pragma("unroll") for (int m = 0; m < 4; ++m) _Pragma("unroll") for (int k = 0; k < 2; ++k) dst[m][k] = *(const PG8_LAS bf16x8*)(lds + PG8_SA(b, h) + aoff + m * 2048 + k * 1024); } while (0)
#define PG8_LDB(dst, b, h) do { _Pragma("unroll") for (int n = 0; n < 2; ++n) _Pragma("unroll") for (int k = 0; k < 2; ++k) dst[n][k] = *(const PG8_LAS bf16x8*)(lds + PG8_SB(b, h) + boff + n * 2048 + k * 1024); } while (0)
#define PG8_MMA(ai, bj, At, Bt) do { __builtin_amdgcn_s_setprio(1); _Pragma("unroll") for (int m = 0; m < 4; ++m) _Pragma("unroll") for (int n = 0; n < 2; ++n) _Pragma("unroll") for (int k = 0; k < 2; ++k) \
        acc[ai][bj][m][n] = __builtin_amdgcn_mfma_f32_16x16x32_bf16(Bt[n][k], At[m][k], acc[ai][bj][m][n], 0, 0, 0); __builtin_amdgcn_s_setprio(0); } while (0)
#define PG8_WAIT_V(n) asm volatile("s_waitcnt vmcnt(" #n ")" ::: "memory")
#define PG8_WAIT_L(n) asm volatile("s_waitcnt lgkmcnt(" #n ")" ::: "memory")
#define PG8_BAR __builtin_amdgcn_s_barrier()
#define PG8_SCHED __builtin_amdgcn_sched_barrier(0)
    Unit cur, nxt; int ui = 0;
    if (!S.next(0, cur)) return;
    f32x4 acc[2][2][4][2];
#pragma unroll
    for (int a = 0; a < 2; ++a)
#pragma unroll
        for (int b = 0; b < 2; ++b)
#pragma unroll
            for (int m = 0; m < 4; ++m)
#pragma unroll
                for (int n = 0; n < 2; ++n) acc[a][b][m][n] = (f32x4){0.f, 0.f, 0.f, 0.f};
    bf16x8 At[4][2], B0[2][2], B1[2][2];
    const char* cA = (const char*)g.A + (size_t)cur.pm * tstep; const char* cB = (const char*)g.Bt + (size_t)cur.pn * tstep;
    S.a_ready(cur);
    if constexpr (SP2) {
        PG8_STAGE(PG8_SB(0, 0), cB, voffB); PG8_STAGE(PG8_SB(0, 1), cB + hstepB, voffB); PG8_STAGE(PG8_SA(0, 0), cA, voffA); PG8_STAGE(PG8_SA(0, 1), cA + hstep, voffA);
        if (wr == 1) PG8_BAR;
        PG8_WAIT_V(2); PG8_BAR;
        PG8_STAGE(PG8_SB(1, 0), cB + kstep, voffB); PG8_STAGE(PG8_SA(1, 0), cA + kstep, voffA); PG8_STAGE(PG8_SB(1, 1), cB + hstepB + kstep, voffB);
        PG8_WAIT_V(6); PG8_BAR;
    } else {
        PG8_STAGE(PG8_SB(0, 0), cB, voffB); PG8_STAGE(PG8_SA(0, 0), cA, voffA); PG8_STAGE(PG8_SB(0, 1), cB + hstepB, voffB); PG8_STAGE(PG8_SA(0, 1), cA + hstep, voffA);
        if (wr == 1) PG8_BAR;
        PG8_WAIT_V(4); PG8_BAR;
        PG8_STAGE(PG8_SB(1, 0), cB + kstep, voffB); PG8_STAGE(PG8_SA(1, 0), cA + kstep, voffA); PG8_STAGE(PG8_SB(1, 1), cB + hstepB + kstep, voffB);
        PG8_WAIT_V(6); PG8_BAR;
    }
    for (;;) {
        const bool has_next = S.next(ui + 1, nxt);
        const char* nA = has_next ? (const char*)g.A + (size_t)nxt.pm * tstep : cA; const char* nB = has_next ? (const char*)g.Bt + (size_t)nxt.pn * tstep : cB;
        for (int t = 0; t < nt; t += 2) {
            const bool last = (t == nt - 2);
            const char* a1 = cA + (size_t)(t + 1) * kstep;
            const char* a2 = last ? nA : cA + (size_t)(t + 2) * kstep; const char* b2 = last ? nB : cB + (size_t)(t + 2) * kstep;
            const char* a3 = a2 + kstep; const char* b3 = b2 + kstep;
            if (last && has_next) S.a_ready(nxt);
            if constexpr (SP2) {
            PG8_LDB(B0, 0, 0); PG8_LDB(B1, 0, 1); PG8_SCHED; PG8_LDA(At, 0, 0); PG8_STAGE(PG8_SA(1, 1), a1 + hstep, voffA);
            PG8_WAIT_V(8); PG8_WAIT_L(0); PG8_BAR; PG8_MMA(0, 0, At, B0); PG8_MMA(0, 1, At, B1); PG8_BAR; PG8_SCHED;
            PG8_LDA(At, 0, 1); PG8_STAGE(PG8_SB(0, 0), b2, voffB); PG8_STAGE(PG8_SB(0, 1), b2 + hstepB, voffB); PG8_STAGE(PG8_SA(0, 0), a2, voffA);
            PG8_WAIT_V(8); PG8_WAIT_L(0); PG8_BAR; PG8_MMA(1, 0, At, B0); PG8_MMA(1, 1, At, B1); PG8_BAR; PG8_SCHED;
            PG8_LDB(B0, 1, 0); PG8_LDB(B1, 1, 1); PG8_SCHED; PG8_LDA(At, 1, 0); PG8_STAGE(PG8_SA(0, 1), a2 + hstep, voffA);
            PG8_WAIT_V(8); PG8_WAIT_L(0); PG8_BAR; PG8_MMA(0, 0, At, B0); PG8_MMA(0, 1, At, B1); PG8_BAR; PG8_SCHED;
            PG8_LDA(At, 1, 1); PG8_STAGE(PG8_SB(1, 0), b3, voffB); PG8_STAGE(PG8_SB(1, 1), b3 + hstepB, voffB); PG8_STAGE(PG8_SA(1, 0), a3, voffA);
            PG8_WAIT_V(8); PG8_WAIT_L(0); PG8_BAR; PG8_MMA(1, 0, At, B0); PG8_MMA(1, 1, At, B1); PG8_BAR; PG8_SCHED;
            } else {
            PG8_LDB(B0, 0, 0); PG8_SCHED; PG8_LDA(At, 0, 0); PG8_STAGE(PG8_SA(1, 1), a1 + hstep, voffA);
            PG8_WAIT_L(8); PG8_BAR; PG8_WAIT_L(0); PG8_MMA(0, 0, At, B0); PG8_BAR; PG8_SCHED;
            PG8_LDB(B1, 0, 1); PG8_STAGE(PG8_SB(0, 0), b2, voffB);
            PG8_BAR; PG8_WAIT_L(0); PG8_MMA(0, 1, At, B1); PG8_BAR;
            PG8_LDA(At, 0, 1); PG8_STAGE(PG8_SA(0, 0), a2, voffA);
            PG8_BAR; PG8_WAIT_L(0); PG8_MMA(1, 0, At, B0); PG8_BAR; PG8_SCHED;
            PG8_STAGE(PG8_SB(0, 1), b2 + hstepB, voffB);
            PG8_WAIT_V(6); PG8_BAR; PG8_MMA(1, 1, At, B1); PG8_BAR;
            PG8_LDB(B0, 1, 0); PG8_SCHED; PG8_LDA(At, 1, 0); PG8_STAGE(PG8_SA(0, 1), a2 + hstep, voffA);
            PG8_WAIT_L(8); PG8_BAR; PG8_WAIT_L(0); PG8_MMA(0, 0, At, B0); PG8_BAR; PG8_SCHED;
            PG8_LDB(B1, 1, 1); PG8_STAGE(PG8_SB(1, 0), b3, voffB);
            PG8_BAR; PG8_WAIT_L(0); PG8_MMA(0, 1, At, B1); PG8_BAR;
            PG8_LDA(At, 1, 1); PG8_STAGE(PG8_SA(1, 0), a3, voffA);
            PG8_BAR; PG8_WAIT_L(0); PG8_MMA(1, 0, At, B0); PG8_BAR; PG8_SCHED;
            PG8_STAGE(PG8_SB(1, 1), b3 + hstepB, voffB);
            PG8_WAIT_V(6); PG8_BAR; PG8_MMA(1, 1, At, B1); PG8_BAR;
            }
        }
        if constexpr (ALIGN_EPI) { if (wr == 0) PG8_BAR; }
        if constexpr (!Epi::AFTER_DRAIN) { E(acc, cur, wr, wc, fr, fq); S.done(cur); }
        if (!has_next) break;
#pragma unroll
        for (int a = 0; a < 2; ++a)
#pragma unroll
            for (int b = 0; b < 2; ++b)
#pragma unroll
                for (int m = 0; m < 4; ++m)
#pragma unroll
                    for (int n = 0; n < 2; ++n) acc[a][b][m][n] = (f32x4){0.f, 0.f, 0.f, 0.f};
        cur = nxt; cA = nA; cB = nB; ++ui;
        if constexpr (ALIGN_EPI) { if (wr == 1) PG8_BAR; }
    }
    PG8_WAIT_V(0);
    if constexpr (!ALIGN_EPI) { if (wr == 0) PG8_BAR; }
    PG8_BAR;
    if constexpr (Epi::AFTER_DRAIN) { E.fused(acc, cur, wr, wc, fr, fq, lds, wid, lane); S.done(cur); }
#undef PG8_SA
#undef PG8_SB
#undef PG8_STAGE
#undef PG8_LDA
#undef PG8_LDB
#undef PG8_MMA
#undef PG8_WAIT_V
#undef PG8_WAIT_L
#undef PG8_BAR
#undef PG8_SCHED
}
}

#include <hip/hip_bf16.h>
#include <cmath>
namespace attn_body {
using bf16=__hip_bfloat16;
using bf16x8=__attribute__((ext_vector_type(8)))short;
using s16x4=__attribute__((ext_vector_type(4)))short;
using f32x16=__attribute__((ext_vector_type(16)))float;
using u32x4=__attribute__((ext_vector_type(4)))unsigned;
constexpr int BATCH=32,NHEAD=8,SEQ=2048,D=64,DM=NHEAD*D;
constexpr int NW=8,QBLK=32,QB=QBLK*NW,KVBLK=64,NQB=SEQ/QB;
constexpr int ATTN_PITCH=DM, ATTN_UNIT_ROWS=QB;
__device__ __forceinline__ int crow(int r,int hi){return (r&3)+8*(r>>2)+4*hi;}
#define SBAR() __builtin_amdgcn_sched_barrier(0)
__device__ __forceinline__ void cmask(f32x16&p0,f32x16&p1,int jb,int qrel,int hi){
  const float NEG=-INFINITY; int kb=64*jb+4*hi;
  #pragma unroll
  for(int r=0;r<16;++r){int kv=kb+(r&3)+8*(r>>2); if(kv>qrel)p0[r]=NEG; if(kv+32>qrel)p1[r]=NEG;}
}

constexpr int NSLOT=3, SLOTB=8192;
constexpr int LDS_K=0, LDS_V=NSLOT*SLOTB, LDS_WS=2*NSLOT*SLOTB, LDS_OST=LDS_WS+NW*64*4, LDS_CB=LDS_OST+NW*4096, LDS_BYTES=LDS_CB+SEQ*4;
constexpr float C2=0.125f*1.4426950408889634f;
__device__ __forceinline__ void glds16(const void*gsrc,unsigned lds_dst){unsigned keep;
  asm volatile("s_mov_b32 %0, m0\n\ts_mov_b32 m0, %2\n\ts_nop 0\n\tglobal_load_lds_dwordx4 %1, off\n\ts_mov_b32 m0, %0":"=&s"(keep):"v"(gsrc),"s"(lds_dst):"memory");}
__device__ __forceinline__ float max3f(float a,float b,float c){float r;asm("v_max3_f32 %0, %1, %2, %3":"=v"(r):"v"(a),"v"(b),"v"(c));return r;}
__device__ __forceinline__ float max2f(float a,float b){float r;asm("v_max_f32_e32 %0, %1, %2":"=v"(r):"v"(a),"v"(b));return r;}
__device__ __forceinline__ float fadd_s(float a,float b){float r;asm("v_add_f32_e32 %0, %1, %2":"=v"(r):"v"(a),"v"(b));return r;}
__device__ __forceinline__ float fsub_s(float a,float b){float r;asm("v_sub_f32_e32 %0, %1, %2":"=v"(r):"v"(a),"v"(b));return r;}
typedef float f32x2_t __attribute__((ext_vector_type(2))); typedef __bf16 bf16x2_t __attribute__((ext_vector_type(2)));
__device__ __forceinline__ unsigned cvtpk_s(float lo,float hi){f32x2_t v={lo,hi};bf16x2_t b=__builtin_convertvector(v,bf16x2_t);return __builtin_bit_cast(unsigned,b);}
#define WAIT_BAR(N) asm volatile("s_waitcnt vmcnt(" #N ") lgkmcnt(0)\n\ts_barrier":::"memory")

__device__ __forceinline__ void qkt(f32x16&p0,f32x16&p1,const char*Kslot,const bf16x8*qr,int r32,int hi){
  const char*kb=Kslot+hi*1024+r32*16;
  #pragma unroll
  for(int d0=0;d0<4;++d0){
    const bf16x8 b0=*reinterpret_cast<const bf16x8*>(kb+d0*2048);
    const bf16x8 b1=*reinterpret_cast<const bf16x8*>(kb+d0*2048+512);
    {p0=__builtin_amdgcn_mfma_f32_32x32x16_bf16(b0,qr[d0],p0,0,0,0);p1=__builtin_amdgcn_mfma_f32_32x32x16_bf16(b1,qr[d0],p1,0,0,0);}}
}
typedef __attribute__((address_space(3))) const char* lds_cptr;
typedef float f32x4_t __attribute__((ext_vector_type(4)));
typedef __attribute__((address_space(3))) const f32x4_t* lds_f4p;
typedef short v4i16_t __attribute__((ext_vector_type(4)));
__device__ __forceinline__ void kload8(bf16x8*kf,lds_cptr kp){
  kf[0]=*(const __attribute__((address_space(3))) bf16x8*)(kp);      kf[1]=*(const __attribute__((address_space(3))) bf16x8*)(kp+512);
  kf[2]=*(const __attribute__((address_space(3))) bf16x8*)(kp+2048); kf[3]=*(const __attribute__((address_space(3))) bf16x8*)(kp+2560);
  kf[4]=*(const __attribute__((address_space(3))) bf16x8*)(kp+4096); kf[5]=*(const __attribute__((address_space(3))) bf16x8*)(kp+4608);
  kf[6]=*(const __attribute__((address_space(3))) bf16x8*)(kp+6144); kf[7]=*(const __attribute__((address_space(3))) bf16x8*)(kp+6656);
}
__device__ __forceinline__ void kload2(bf16x8*kf,lds_cptr kp,int j){ kf[2*j]=*(const __attribute__((address_space(3))) bf16x8*)(kp+j*2048); kf[2*j+1]=*(const __attribute__((address_space(3))) bf16x8*)(kp+j*2048+512); }
__device__ __forceinline__ s16x4 vtr(lds_cptr p){ return __builtin_bit_cast(s16x4,__builtin_amdgcn_ds_read_tr16_b64_v4i16((__attribute__((address_space(3))) v4i16_t*)p)); }
__device__ __forceinline__ float rowmax(const f32x16&p0,const f32x16&p1){
  float a=max3f(p0[0],p0[1],p1[0]),b=max3f(p0[2],p0[3],p1[1]);a=max3f(a,p1[2],p1[3]);
  #pragma unroll
  for(int r=4;r<16;r+=4){a=max3f(a,p0[r],p0[r+1]);b=max3f(b,p0[r+2],p0[r+3]);a=max3f(a,p1[r],p1[r+1]);b=max3f(b,p1[r+2],p1[r+3]);}
  const float m=max2f(a,b);
  auto rr=__builtin_amdgcn_permlane32_swap(__float_as_uint(m),__float_as_uint(m),false,false);
  return max2f(__uint_as_float(rr[0]),__uint_as_float(rr[1]));
}
__device__ __forceinline__ void pv(f32x16*o,int vb,bf16x8 pa0,bf16x8 pa1,bf16x8 pa2,bf16x8 pa3){
  #pragma unroll
  for(int d0=0;d0<2;++d0){s16x4 lo[4],hi[4];
    #pragma unroll
    for(int ks=0;ks<4;++ks){
      asm volatile("ds_read_b64_tr_b16 %0,%1 offset:%c2":"=&v"(lo[ks]):"v"(vb),"i"(d0*4096+ks*1024):"memory");
      asm volatile("ds_read_b64_tr_b16 %0,%1 offset:%c2":"=&v"(hi[ks]):"v"(vb),"i"(d0*4096+ks*1024+512):"memory");}
    asm volatile("s_waitcnt lgkmcnt(0)":::"memory");SBAR();
    #define PK(k) (bf16x8){lo[k][0],lo[k][1],lo[k][2],lo[k][3],hi[k][0],hi[k][1],hi[k][2],hi[k][3]}
    o[d0]=__builtin_amdgcn_mfma_f32_32x32x16_bf16(pa0,PK(0),o[d0],0,0,0);
    o[d0]=__builtin_amdgcn_mfma_f32_32x32x16_bf16(pa1,PK(1),o[d0],0,0,0);
    o[d0]=__builtin_amdgcn_mfma_f32_32x32x16_bf16(pa2,PK(2),o[d0],0,0,0);
    o[d0]=__builtin_amdgcn_mfma_f32_32x32x16_bf16(pa3,PK(3),o[d0],0,0,0);
    #undef PK
  }
}

#ifndef ATTN_STORE16
#define ATTN_STORE16(p,v) (*(u32x4*)(p)=(v))
#endif
template<int THRL> __device__ __forceinline__ void attn_unit(int b,int h,int qb,const bf16*Q,const bf16*__restrict__ K,const bf16*__restrict__ V,bf16*O,const float*cbg,char*shm){
  int tid_l=threadIdx.x; asm volatile("":"+v"(tid_l)); const int tid=tid_l,lane=tid&63,r32=lane&31,hi=lane>>5; const int wid=__builtin_amdgcn_readfirstlane(tid>>6);
  const long rowbase=(long)b*SEQ; const int q0=qb*QB;
  const bf16*Qw=Q+(rowbase+q0+wid*QBLK)*DM+h*D;
  const bf16*Kh=K+rowbase*DM+h*D,*Vh=V+rowbase*DM+h*D;
  const unsigned lds0=(unsigned)(uintptr_t)shm;
  float*wsf=(float*)(shm+LDS_WS)+wid*64;
  const bf16*ksrc=Kh+(long)lane*DM+wid*8;
  const bf16*vsrc=Vh+(long)(16*(wid&3)+(lane>>2))*DM+(wid>>2)*32+(lane&3)*8;
  const unsigned kdst=lds0+LDS_K+wid*1024, vdst=lds0+LDS_V+wid*1024;
  #define DMA_K(t,slot) glds16(ksrc+(long)(t)*KVBLK*DM,(unsigned)__builtin_amdgcn_readfirstlane(kdst+(slot)))
  #define DMA_V(t,slot) glds16(vsrc+(long)(t)*KVBLK*DM,(unsigned)__builtin_amdgcn_readfirstlane(vdst+(slot)))
  const int vb0=(int)(lds0+LDS_V)+((lane>>4)&1)*32+(lane&3)*8+(4*hi+((lane&15)>>2))*64;
  const char*Kbase=shm+LDS_K; bf16x8 kf[8];
  const lds_cptr shm3=(lds_cptr)shm; const lds_cptr kp0=shm3+LDS_K+hi*1024+r32*16; const lds_cptr vp0=shm3+LDS_V+((lane>>4)&1)*32+(lane&3)*8+(4*hi+((lane&15)>>2))*64;
  const int NT=(q0+QB)/KVBLK;
  { const f32x4_t cv_=*reinterpret_cast<const f32x4_t*>(cbg+4*tid); *(__attribute__((address_space(3))) f32x4_t*)((lds_cptr)shm+LDS_CB+16*tid)=cv_; }
  const lds_f4p cb4=(lds_f4p)((lds_cptr)shm+LDS_CB);
  #define BINIT(P0,P1,t) do{ const lds_f4p bp_=cb4+((t)*16+hi); _Pragma("unroll") for(int g_=0;g_<4;++g_){ const f32x4_t b0_=bp_[2*g_], b1_=bp_[2*g_+8]; \
      P0[4*g_]=b0_[0]-mhat; P0[4*g_+1]=b0_[1]-mhat; P0[4*g_+2]=b0_[2]-mhat; P0[4*g_+3]=b0_[3]-mhat; \
      P1[4*g_]=b1_[0]-mhat; P1[4*g_+1]=b1_[1]-mhat; P1[4*g_+2]=b1_[2]-mhat; P1[4*g_+3]=b1_[3]-mhat; } }while(0)
  DMA_K(0,0);DMA_V(0,0);DMA_K(1,SLOTB);
  bf16x8 qr[4];
  #pragma unroll
  for(int d0=0;d0<4;++d0)qr[d0]=*reinterpret_cast<const bf16x8*>(&Qw[(long)r32*DM+d0*16+hi*8]);
  float mhat=0.f,l_reg=0.f;f32x16 o[2];o[0]=f32x16{};o[1]=f32x16{};
  const int qrel=wid*QBLK+r32;
  #define CMASK(P0,P1,t) do{int jb_=(t)-(NT-4); if(jb_>=0)cmask(P0,P1,jb_,qrel,hi);}while(0)
  bool resc=false;
  #define START(P0,P1) do{ const float rm=rowmax(P0,P1); resc=false; \
    { const float dl=rm; mhat=fadd_s(mhat,dl); \
      _Pragma("unroll") for(int r=0;r<16;++r){P0[r]=fsub_s(P0[r],dl);P1[r]=fsub_s(P1[r],dl);} \
      } \
    _Pragma("unroll") for(int r=0;r<16;++r)P0[r]=__builtin_amdgcn_exp2f(P0[r]); }while(0)
  #define RESC() do{ if(resc){ asm volatile("s_waitcnt lgkmcnt(0)":::"memory"); \
      _Pragma("unroll") for(int d_=0;d_<2;++d_) _Pragma("unroll") for(int r=0;r<16;++r)o[d_][r]*=wsf[crow(r,hi)]; } }while(0)
  f32x16 pA0,pA1,pB0,pB1;
  int sl_prev=0,sl_cur=0,sl_next=SLOTB;
  #define ROT() do{sl_prev=sl_cur;sl_cur=sl_next;sl_next=(sl_next==(NSLOT-1)*SLOTB)?0:sl_next+SLOTB;}while(0)
  DMA_K(2,2*SLOTB);
  WAIT_BAR(3);
  BINIT(pA0,pA1,0); qkt(pA0,pA1,Kbase,qr,r32,hi);asm volatile("s_nop 15\n\ts_nop 7":"+v"(pA0),"+v"(pA1));CMASK(pA0,pA1,0);
  START(pA0,pA1);
  _Pragma("unroll") for(int r=0;r<16;++r)pA1[r]=__builtin_amdgcn_exp2f(pA1[r]);
  WAIT_BAR(0);
  DMA_K(3,0);DMA_V(1,SLOTB);
  ROT();
  kload8(kf,kp0+sl_cur);
  WAIT_BAR(2);
  s16x4 vlo[8],vhi[8]; u32x4 pw0,pw1,pw2,pw3;
  #define PKW(P,B) cvtpk_s(P[B],P[B+1])
  #define PAF(k) __builtin_bit_cast(bf16x8,pw##k)
  #define VFR(i) (bf16x8){vlo[i][0],vlo[i][1],vlo[i][2],vlo[i][3],vhi[i][0],vhi[i][1],vhi[i][2],vhi[i][3]}
  #define PIN(x) asm volatile("":"+v"(x))
  #define MX3(a,b,c) __builtin_fmaxf(__builtin_fmaxf((a),(b)),(c))
  #define GAPA(MF,A0,A1,A2,A3,W0,W1,PW) do{ MF; sacc+=A0; sacc+=A1; sacc+=A2; sacc+=A3; PIN(sacc); W0; W1; PIN(PW); SBAR(); }while(0)
  #define EX(v) __builtin_amdgcn_exp2f(v)
  #define GAPB(MF,X,B) do{ MF; X[B]=EX(X[B]); X[B+1]=EX(X[B+1]); X[B+2]=EX(X[B+2]); X[B+3]=EX(X[B+3]); PIN(X); SBAR(); }while(0)
  #define VRD(i) do{ vlo[i]=vtr(vp_+(((i)>>2)*4096+((i)&3)*1024)); vhi[i]=vtr(vp_+(((i)>>2)*4096+((i)&3)*1024+512)); }while(0)
  #define KRD(G,j) do{ if(G){ kload2(kf,kp0+sl_next,j); SBAR(); } }while(0)
  #define STEP(C0,C1,P0,P1,t,GK,GV,GL) do{ BINIT(C0,C1,t); SBAR(); \
    const lds_cptr vp_=vp0+sl_prev; \
    VRD(0); SBAR(); float sacc=(P0[0]+P0[1]); \
    GAPA(C0=__builtin_amdgcn_mfma_f32_32x32x16_bf16(kf[0],qr[0],C0,0,0,0), P0[2],P0[3],P0[4],P0[5],     pw0[0]=PKW(P0,0), pw0[1]=PKW(P0,2), pw0); \
    VRD(4); SBAR(); GAPA(C1=__builtin_amdgcn_mfma_f32_32x32x16_bf16(kf[1],qr[0],C1,0,0,0), P0[6],P0[7],P0[8],P0[9],     pw0[2]=PKW(P0,4), pw0[3]=PKW(P0,6), pw0); \
    VRD(1); SBAR(); GAPA(C0=__builtin_amdgcn_mfma_f32_32x32x16_bf16(kf[2],qr[1],C0,0,0,0),   P0[10],P0[11],P0[12],P0[13], pw1[0]=PKW(P0,8), pw1[1]=PKW(P0,10), pw1); \
    VRD(5); SBAR(); GAPA(C1=__builtin_amdgcn_mfma_f32_32x32x16_bf16(kf[3],qr[1],C1,0,0,0),   P0[14],P0[15],P1[0],P1[1],   pw1[2]=PKW(P0,12),pw1[3]=PKW(P0,14), pw1); \
    VRD(2); SBAR(); GAPA(C0=__builtin_amdgcn_mfma_f32_32x32x16_bf16(kf[4],qr[2],C0,0,0,0),   P1[2],P1[3],P1[4],P1[5],     pw2[0]=PKW(P1,0), pw2[1]=PKW(P1,2), pw2); \
    VRD(6); SBAR(); GAPA(C1=__builtin_amdgcn_mfma_f32_32x32x16_bf16(kf[5],qr[2],C1,0,0,0),   P1[6],P1[7],P1[8],P1[9],     pw2[2]=PKW(P1,4), pw2[3]=PKW(P1,6), pw2); \
    VRD(3); SBAR(); GAPA(C0=__builtin_amdgcn_mfma_f32_32x32x16_bf16(kf[6],qr[3],C0,0,0,0),   P1[10],P1[11],P1[12],P1[13], pw3[0]=PKW(P1,8), pw3[1]=PKW(P1,10), pw3); \
    VRD(7); SBAR(); GAPA(C1=__builtin_amdgcn_mfma_f32_32x32x16_bf16(kf[7],qr[3],C1,0,0,0),   P1[14],P1[15],0.f,0.f,       pw3[2]=PKW(P1,12),pw3[3]=PKW(P1,14), pw3); \
    l_reg+=sacc; \
    if(GK){DMA_K((t)+3,sl_cur);} if(GV){DMA_V((t)+1,sl_next);} \
    CMASK(C0,C1,t); \
    { float a=MX3(C0[0],C0[1],C1[0]),b=MX3(C0[2],C0[3],C1[1]); a=MX3(a,C1[2],C1[3]); \
      _Pragma("unroll") for(int r=4;r<16;r+=4){a=MX3(a,C0[r],C0[r+1]);b=MX3(b,C0[r+2],C0[r+3]);a=MX3(a,C1[r],C1[r+1]);b=MX3(b,C1[r+2],C1[r+3]);} \
      float rm=__builtin_fmaxf(a,b); { auto rr=__builtin_amdgcn_permlane32_swap(__float_as_uint(rm),__float_as_uint(rm),false,false); rm=__builtin_fmaxf(__uint_as_float(rr[0]),__uint_as_float(rr[1])); } \
      resc=false; \
      if(__builtin_expect(__any(rm>(float)THRL),0)){ const float dl=__builtin_fmaxf(rm,0.f); mhat+=dl; \
        _Pragma("unroll") for(int r=0;r<16;++r){C0[r]-=dl;C1[r]-=dl;} \
        const float f=__builtin_amdgcn_exp2f(-dl); l_reg*=f; if(hi==0)wsf[r32]=f; resc=true; } } \
    SBAR(); \
    GAPB(o[0]=__builtin_amdgcn_mfma_f32_32x32x16_bf16(PAF(0),VFR(0),o[0],0,0,0), C0,0); \
    GAPB(o[1]=__builtin_amdgcn_mfma_f32_32x32x16_bf16(PAF(0),VFR(4),o[1],0,0,0), C0,4); \
    KRD(GL,0); GAPB(o[0]=__builtin_amdgcn_mfma_f32_32x32x16_bf16(PAF(1),VFR(1),o[0],0,0,0), C0,8); \
    KRD(GL,1); GAPB(o[1]=__builtin_amdgcn_mfma_f32_32x32x16_bf16(PAF(1),VFR(5),o[1],0,0,0), C0,12); \
    KRD(GL,2); GAPB(o[0]=__builtin_amdgcn_mfma_f32_32x32x16_bf16(PAF(2),VFR(2),o[0],0,0,0), C1,0); \
    KRD(GL,3); GAPB(o[1]=__builtin_amdgcn_mfma_f32_32x32x16_bf16(PAF(2),VFR(6),o[1],0,0,0), C1,4); \
    GAPB(o[0]=__builtin_amdgcn_mfma_f32_32x32x16_bf16(PAF(3),VFR(3),o[0],0,0,0), C1,8); \
    GAPB(o[1]=__builtin_amdgcn_mfma_f32_32x32x16_bf16(PAF(3),VFR(7),o[1],0,0,0), C1,12); \
    }while(0)
  int t=1;
  #undef CMASK
  #define CMASK(P0,P1,t) do{}while(0)
  for(;t+5<NT;t+=2){
    STEP(pB0,pB1,pA0,pA1,t,true,true,true);     WAIT_BAR(2); RESC(); ROT();
    STEP(pA0,pA1,pB0,pB1,t+1,true,true,true);   WAIT_BAR(2); RESC(); ROT();
  }
  #undef CMASK
  #define CMASK(P0,P1,t) do{int jb_=(t)-(NT-4); if(jb_>=0)cmask(P0,P1,jb_,qrel,hi);}while(0)
  #define ENDW(tt) do{ if((tt)+3<NT){WAIT_BAR(2);} else if((tt)+2<NT){WAIT_BAR(1);} else {WAIT_BAR(0);} }while(0)
  for(;t+1<NT;t+=2){
    STEP(pB0,pB1,pA0,pA1,t,(t+3<NT),(t+1<NT),(t+1<NT));       ENDW(t);   RESC(); ROT();
    STEP(pA0,pA1,pB0,pB1,t+1,(t+4<NT),(t+2<NT),(t+2<NT));     ENDW(t+1); RESC(); ROT();
  }
  STEP(pB0,pB1,pA0,pA1,NT-1,false,false,false); RESC();
  { float sacc=pB0[0]+pB0[1]; _Pragma("unroll") for(int r=2;r<16;++r)sacc+=pB0[r]; _Pragma("unroll") for(int r=0;r<16;++r)sacc+=pB1[r]; l_reg+=sacc;
    pw0=(u32x4){PKW(pB0,0),PKW(pB0,2),PKW(pB0,4),PKW(pB0,6)};pw1=(u32x4){PKW(pB0,8),PKW(pB0,10),PKW(pB0,12),PKW(pB0,14)};pw2=(u32x4){PKW(pB1,0),PKW(pB1,2),PKW(pB1,4),PKW(pB1,6)};pw3=(u32x4){PKW(pB1,8),PKW(pB1,10),PKW(pB1,12),PKW(pB1,14)};
    SBAR(); pv(o,vb0+sl_cur,PAF(0),PAF(1),PAF(2),PAF(3)); }
  #undef PKW
  #undef PAF
  #undef VFR
  #undef PIN
  #undef MX3
  #undef GAPA
  #undef GAPB
  #undef EX
  #undef VRD
  #undef KRD
  #undef STEP
  #undef ENDW
  {auto rr=__builtin_amdgcn_permlane32_swap(__float_as_uint(l_reg),__float_as_uint(l_reg),false,false);l_reg=__uint_as_float(rr[0])+__uint_as_float(rr[1]);}
  if(hi==0)wsf[32+r32]=l_reg;asm volatile("s_waitcnt lgkmcnt(0)":::"memory");
  float rli[16];
  #pragma unroll
  for(int r=0;r<16;++r)rli[r]=__builtin_amdgcn_rcpf(wsf[32+crow(r,hi)]);
  bf16*Ow=O+(rowbase+q0+wid*QBLK)*DM+h*D;
  { bf16*stg=(bf16*)(shm+LDS_OST)+wid*2048;
    #pragma unroll
    for(int r=0;r<16;++r){const int orow=crow(r,hi);
      #pragma unroll
      for(int d0=0;d0<2;++d0)stg[orow*64+d0*32+r32]=__float2bfloat16(o[d0][r]*rli[r]);}
    asm volatile("s_waitcnt lgkmcnt(0)":::"memory");
    #pragma unroll
    for(int i=0;i<4;++i){const int row=i*8+(lane>>3),ch=lane&7; const u32x4 v=*(const u32x4*)(stg+row*64+ch*8); ATTN_STORE16(Ow+(long)row*DM+ch*8,v);} }
  asm volatile("s_waitcnt lgkmcnt(0)\n\ts_barrier":::"memory");
  #undef BINIT
  #undef DMA_K
  #undef DMA_V
  #undef CMASK
  #undef START
  #undef RESC
  #undef ROT
}
constexpr int ATTN_LDS_BYTES=LDS_BYTES;
#undef SBAR
#undef WAIT_BAR
}

#define LAS __attribute__((address_space(3)))
typedef unsigned short bf16;
typedef unsigned v4u __attribute__((ext_vector_type(4)));
typedef unsigned v2u __attribute__((ext_vector_type(2)));
typedef float f32x4 __attribute__((ext_vector_type(4)));
typedef short bf16x8 __attribute__((ext_vector_type(8)));
__device__ __forceinline__ unsigned f2bf(float f) { unsigned u = __builtin_bit_cast(unsigned, f); return (u + 0x7fffu + ((u >> 16) & 1u)) >> 16; }
__device__ __forceinline__ unsigned pk2(float lo, float hi) { return f2bf(lo) | (f2bf(hi) << 16); }
__device__ __forceinline__ float bf2f(unsigned b) { return __uint_as_float(b << 16); }
__device__ __forceinline__ float wave_sum(float v) {
#pragma unroll
    for (int o = 1; o < 64; o <<= 1) v += __shfl_xor(v, o);
    return v;
}
__device__ __forceinline__ float wave_max(float v) {
#pragma unroll
    for (int o = 1; o < 64; o <<= 1) v = fmaxf(v, __shfl_xor(v, o));
    return v;
}
__device__ __forceinline__ float sigm(float z) { return __builtin_amdgcn_rcpf(1.0f + __builtin_amdgcn_exp2f(-1.4426950408889634f * z)); }

constexpr size_t MiB = 1u << 20;
constexpr size_t WS_SS = 1 * MiB, WS_CB = 3 * MiB, WS_W = 8 * MiB, WS_WL = 24 * MiB, WS_XB = 64 * MiB, WS_ACT = 200 * MiB;
constexpr size_t SLOT = (size_t)M_ * 512 * 2;
constexpr size_t WS_END = WS_ACT + 8 * SLOT;
constexpr int LDS_BYTES = 147456;
constexpr int NPHASE = 15;
#ifndef PHMASK
#define PHMASK 0x3ff
#endif
#define PK(j) (((PHMASK) >> (j)) & 1)

constexpr size_t O_Y = 0, O_KP = 67633152, O_VP = 134742016, O_LFP = 201850880, O_HP = 202899456, O_CP = 202932224,
                 O_KS = 203030528, O_VS = 203554816, O_LFS = 204079104, O_HS = 204087296, O_CS = 204120064, O_END = 204218368;

struct Args { const float* in[25]; float* out; unsigned char* ws; int ph_lo, ph_hi; };

template <int MODE>
__device__ __forceinline__ void transpose_item(const float* W, int K, int Nsrc, const float* gain, const float* gain2, bf16* WT, LAS float* scr, int kb, int nb, int lane) {
    const int k0 = 64 * kb, n0 = 32 * nb;
    int sc = n0 + (lane & 31);
    if (MODE == 1) { const int r = sc; sc = r < 1536 ? r : (r < 2560 ? r + 8 : (r < 2568 ? r - 1024 : -1)); }
#pragma unroll 8
    for (int i = 0; i < 32; ++i) { const int kk = 2 * i + (lane >> 5); const int k = k0 + kk;
        float gsc = 1.f; if (gain) gsc = (gain2 && k >= 512) ? gain2[k - 512] : gain[k];
        scr[kk * 33 + (lane & 31)] = sc >= 0 ? W[(size_t)k * Nsrc + sc] * gsc : 0.f; }
    asm volatile("s_waitcnt lgkmcnt(0)" ::: "memory");
    const int c = lane & 7;
#pragma unroll
    for (int j = 0; j < 4; ++j) { const int n = (lane >> 3) + 8 * j; const LAS float* s = scr + (8 * c) * 33 + n;
        v4u o; o.x = pk2(s[0 * 33], s[1 * 33]); o.y = pk2(s[2 * 33], s[3 * 33]); o.z = pk2(s[4 * 33], s[5 * 33]); o.w = pk2(s[6 * 33], s[7 * 33]);
        *(v4u*)(WT + (size_t)(n0 + n) * K + k0 + 8 * c) = o; }
    asm volatile("s_waitcnt lgkmcnt(0)" ::: "memory");
}

struct LayerP {
    const float *conv_w, *conv_b, *wga, *bga, *wgx, *bgx, *lam, *state_h, *state_conv;
    const bf16 *XR, *YG; bf16* LRUO;
    float *h_p, *conv_p, *h_s, *conv_s;
};

__device__ __forceinline__ void lru_unit(LAS unsigned char* lds, const int tid, const LayerP& P, const int b, const int n, const bool samp) {
    LAS bf16* WT = (LAS bf16*)(lds);
    LAS float* xrS = (LAS float*)(lds + 18432);
    LAS float* xcS = (LAS float*)(lds + 35584);
    LAS bf16* xcB = (LAS bf16*)(lds + 51968);
    LAS float* aS = (LAS float*)(lds + 61184);
    LAS float* bS = (LAS float*)(lds + 77568);
    LAS float* sgA = (LAS float*)(lds + 93952);
    LAS float* sgB = (LAS float*)(lds + 96000);
    LAS float* hS = (LAS float*)(lds + 98048);
    const int lane = tid & 63, w = tid >> 6;
    const int Tn = samp ? DT_ : T_; const int R0 = samp ? MP_ + b * DT_ : b * T_; const int ch0 = n * 64;
    for (int e = tid; e < 8192; e += 512) { const int c = e >> 7, j = e & 127;
        const float v = (j < 64) ? P.wga[(size_t)(ch0 + c) * 64 + j] : P.wgx[(size_t)(ch0 + c) * 64 + (j - 64)];
        WT[j * 72 + c] = (bf16)f2bf(v); }
    if (tid < 64) hS[tid] = samp ? P.state_h[b * 512 + ch0 + tid] : 0.f;
    const float cw0 = P.conv_w[0 * 512 + ch0 + lane], cw1 = P.conv_w[1 * 512 + ch0 + lane], cw2 = P.conv_w[2 * 512 + ch0 + lane], cw3 = P.conv_w[3 * 512 + ch0 + lane], cbb = P.conv_b[ch0 + lane];
    const int jt = w & 3, th = w >> 2, cm = 16 * jt + (lane & 15);
    const float ba = P.bga[ch0 + cm], bx = P.bgx[ch0 + cm];
    const float sp8 = 8.0f * LOG2E_ * log1pf(__expf(-P.lam[ch0 + cm]));
    __syncthreads();
    bf16x8 Ba[2], Bx[2];
#pragma unroll
    for (int ks = 0; ks < 2; ++ks) {
        Ba[ks] = *(const LAS bf16x8*)(WT + (16 * jt + (lane & 15)) * 72 + 32 * ks + 8 * (lane >> 4));
        Bx[ks] = *(const LAS bf16x8*)(WT + (64 + 16 * jt + (lane & 15)) * 72 + 32 * ks + 8 * (lane >> 4));
    }
    for (int t0 = 0; t0 < Tn; t0 += 64) {
        const int nvalid = (Tn - t0) < 64 ? (Tn - t0) : 64;
        for (int e = tid; e < 67 * 64; e += 512) { const int i = e >> 6, c = e & 63; const int tau = t0 + i - 3; float v = 0.f;
            if (tau >= 0) { if (tau < Tn) v = bf2f(P.XR[(size_t)(R0 + tau) * 512 + ch0 + c]); }
            else if (samp) v = P.state_conv[(size_t)(b * 3 + (tau + 3)) * 512 + ch0 + c];
            xrS[e] = v; }
        __syncthreads();
#pragma unroll
        for (int i = 0; i < 8; ++i) { const int t = w + 8 * i;
            const float v = cbb + cw0 * xrS[t * 64 + lane] + cw1 * xrS[(t + 1) * 64 + lane] + cw2 * xrS[(t + 2) * 64 + lane] + cw3 * xrS[(t + 3) * 64 + lane];
            xcS[t * 64 + lane] = v; xcB[t * 72 + lane] = (bf16)f2bf(v); }
        __syncthreads();
#pragma unroll
        for (int q = 0; q < 2; ++q) { const int tt = 2 * th + q; f32x4 da = {0.f, 0.f, 0.f, 0.f}, dx = {0.f, 0.f, 0.f, 0.f};
#pragma unroll
            for (int ks = 0; ks < 2; ++ks) { const bf16x8 A = *(const LAS bf16x8*)(xcB + (16 * tt + (lane & 15)) * 72 + 32 * ks + 8 * (lane >> 4));
                da = __builtin_amdgcn_mfma_f32_16x16x32_bf16(A, Ba[ks], da, 0, 0, 0); dx = __builtin_amdgcn_mfma_f32_16x16x32_bf16(A, Bx[ks], dx, 0, 0, 0); }
#pragma unroll
            for (int r = 0; r < 4; ++r) { const int t = 16 * tt + 4 * (lane >> 4) + r;
                const float rg = sigm(da[r] + ba), ig = sigm(dx[r] + bx); const float xc = xcS[t * 64 + cm];
                const float a = __builtin_amdgcn_exp2f(-sp8 * rg); const float bb = sqrtf(fmaxf(1.0f - a * a, 0.f)) * ig * xc;
                aS[t * 64 + cm] = a; bS[t * 64 + cm] = bb; } }
        __syncthreads();
        float av[8], bv[8]; float Ac = 1.f, Bc = 0.f;
#pragma unroll
        for (int k = 0; k < 8; ++k) { av[k] = aS[(8 * w + k) * 64 + lane]; bv[k] = bS[(8 * w + k) * 64 + lane]; Bc = av[k] * Bc + bv[k]; Ac *= av[k]; }
        sgA[w * 64 + lane] = Ac; sgB[w * 64 + lane] = Bc;
        __syncthreads();
        float h = hS[lane];
        for (int s = 0; s < w; ++s) h = sgA[s * 64 + lane] * h + sgB[s * 64 + lane];
        float hfin = 0.f; const bool owner = ((nvalid - 1) >> 3) == w;
#pragma unroll
        for (int k = 0; k < 8; ++k) { const int t = 8 * w + k; h = av[k] * h + bv[k];
            if (t < nvalid) { const size_t o = (size_t)(R0 + t0 + t) * 512 + ch0 + lane; const float g = bf2f(P.YG[o]); P.LRUO[o] = (bf16)f2bf(g * h); }
            if (k == ((nvalid - 1) & 7)) hfin = h; }
        __syncthreads();
        if (owner) hS[lane] = hfin;
        if (t0 + 64 >= Tn) {
            float* ho = samp ? P.h_s : P.h_p; float* co = samp ? P.conv_s : P.conv_p;
            if (owner) ho[b * 512 + ch0 + lane] = hfin;
            if (tid < 192) co[(size_t)(b * 3 + w) * 512 + ch0 + lane] = xrS[(nvalid + w) * 64 + lane];
        }
    }
    __syncthreads();
}

__device__ __forceinline__ void cumsum_unit(LAS unsigned char* lds, const int tid, const float* lf  , float* cbo) {
    LAS float* wt = (LAS float*)lds;
    const int lane = tid & 63, w = tid >> 6;
    float v[4];
#pragma unroll
    for (int i = 0; i < 4; ++i) v[i] = lf[(size_t)(4 * tid + i) * 8];
    const float s = (v[0] + v[1]) + (v[2] + v[3]); float inc = s;
#pragma unroll
    for (int o = 1; o < 64; o <<= 1) { const float y = __shfl_up(inc, o); if (lane >= o) inc += y; }
    if (lane == 63) wt[w] = inc;
    __syncthreads();
    float off = 0.f; for (int i = 0; i < w; ++i) off += wt[i];
    float c = off + inc - s; f32x4 o;
#pragma unroll
    for (int i = 0; i < 4; ++i) { c += v[i]; o[i] = -c * LOG2E_; }
    *(f32x4*)(cbo + 4 * tid) = o;
    __syncthreads();
}

struct SampP { const bf16* Q; bf16* O; const float *ck, *cv, *clf, *ks, *vs, *lfs; };
__device__ __forceinline__ void sattn_unit(LAS unsigned char* lds, const int tid, const SampP& P, const int b, const int h) {
    constexpr int NK = PAST_ + DT_, SP = 1064;
    LAS float* cbs = (LAS float*)(lds);
    LAS float* S = (LAS float*)(lds + 4352);
    LAS float* red = (LAS float*)(lds + 72448);
    LAS float* wt = (LAS float*)(lds + 105216);
    const int lane = tid & 63, w = tid >> 6, l15 = lane & 15, l4 = lane >> 4;
    {
        float v[3];
#pragma unroll
        for (int i = 0; i < 3; ++i) { const int j = 3 * tid + i; v[i] = 0.f;
            if (j < PAST_) v[i] = P.clf[((size_t)b * PAST_ + j) * 8 + h]; else if (j < NK) v[i] = P.lfs[((size_t)b * DT_ + (j - PAST_)) * 8 + h]; }
        const float s = v[0] + v[1] + v[2]; float inc = s;
#pragma unroll
        for (int o = 1; o < 64; o <<= 1) { const float y = __shfl_up(inc, o); if (lane >= o) inc += y; }
        if (lane == 63) wt[w] = inc;
        __syncthreads();
        float off = 0.f; for (int i = 0; i < w; ++i) off += wt[i];
        float c = off + inc - s;
#pragma unroll
        for (int i = 0; i < 3; ++i) { const int j = 3 * tid + i; c += v[i]; if (j < NK) cbs[j] = -c * LOG2E_; }
    }
    __syncthreads();
    {
        const bf16* qrow = P.Q + (size_t)(MP_ + b * DT_ + l15) * 512 + h * 64;
        bf16x8 Qf[2];
#pragma unroll
        for (int ks = 0; ks < 2; ++ks) Qf[ks] = *(const bf16x8*)(qrow + 32 * ks + 8 * l4);
        for (int g = w; g < NK / 16; g += 8) {
            const int key = 16 * g + l15;
            const float* kp = key < PAST_ ? P.ck + (((size_t)b * PAST_ + key) * 8 + h) * 64 : P.ks + ((size_t)(b * DT_ + key - PAST_) * 512 + h * 64);
            f32x4 d = {0.f, 0.f, 0.f, 0.f};
#pragma unroll
            for (int ks = 0; ks < 2; ++ks) { const f32x4 k0 = *(const f32x4*)(kp + 32 * ks + 8 * l4), k1 = *(const f32x4*)(kp + 32 * ks + 8 * l4 + 4);
                v4u pk; pk.x = pk2(k0[0], k0[1]); pk.y = pk2(k0[2], k0[3]); pk.z = pk2(k1[0], k1[1]); pk.w = pk2(k1[2], k1[3]);
                d = __builtin_amdgcn_mfma_f32_16x16x32_bf16(Qf[ks], __builtin_bit_cast(bf16x8, pk), d, 0, 0, 0); }
            const float cbk = cbs[key];
#pragma unroll
            for (int r = 0; r < 4; ++r) { const int q = 4 * l4 + r; float s = d[r] + cbk; if (key - PAST_ > q) s = -INFINITY; S[q * SP + key] = s; }
        }
    }
    __syncthreads();
#pragma unroll
    for (int qq = 0; qq < 2; ++qq) { const int q = 2 * w + qq; float m = -INFINITY;
        for (int j = lane; j < NK; j += 64) m = fmaxf(m, S[q * SP + j]);
        m = wave_max(m); float sum = 0.f;
        for (int j = lane; j < NK; j += 64) { const float p = __builtin_amdgcn_exp2f(S[q * SP + j] - m); S[q * SP + j] = p; sum += p; }
        if (lane < 16) S[q * SP + NK + lane] = 0.f;
        sum = wave_sum(sum); if (lane == 0) wt[16 + q] = sum; }
    __syncthreads();
    {
        f32x4 acc[4];
#pragma unroll
        for (int dt = 0; dt < 4; ++dt) acc[dt] = (f32x4){0.f, 0.f, 0.f, 0.f};
        for (int ch = w; ch < 33; ch += 8) {
            const int key0 = 32 * ch + 8 * l4;
            const f32x4 p0 = *(const LAS f32x4*)(S + l15 * SP + key0), p1 = *(const LAS f32x4*)(S + l15 * SP + key0 + 4);
            v4u pp; pp.x = pk2(p0[0], p0[1]); pp.y = pk2(p0[2], p0[3]); pp.z = pk2(p1[0], p1[1]); pp.w = pk2(p1[2], p1[3]);
            const bf16x8 Pf = __builtin_bit_cast(bf16x8, pp);
            float vv[4][8];
#pragma unroll
            for (int jj = 0; jj < 8; ++jj) { int key = key0 + jj; key = key < NK ? key : NK - 1;
                const float* vp = key < PAST_ ? P.cv + (((size_t)b * PAST_ + key) * 8 + h) * 64 : P.vs + ((size_t)(b * DT_ + key - PAST_) * 512 + h * 64);
#pragma unroll
                for (int dt = 0; dt < 4; ++dt) vv[dt][jj] = vp[16 * dt + l15]; }
#pragma unroll
            for (int dt = 0; dt < 4; ++dt) { v4u pv_; pv_.x = pk2(vv[dt][0], vv[dt][1]); pv_.y = pk2(vv[dt][2], vv[dt][3]); pv_.z = pk2(vv[dt][4], vv[dt][5]); pv_.w = pk2(vv[dt][6], vv[dt][7]);
                acc[dt] = __builtin_amdgcn_mfma_f32_16x16x32_bf16(Pf, __builtin_bit_cast(bf16x8, pv_), acc[dt], 0, 0, 0); }
        }
#pragma unroll
        for (int dt = 0; dt < 4; ++dt)
#pragma unroll
            for (int r = 0; r < 4; ++r) red[(w * 16 + 4 * l4 + r) * 64 + 16 * dt + l15] = acc[dt][r];
    }
    __syncthreads();
#pragma unroll
    for (int i = 0; i < 2; ++i) { const int e = tid + 512 * i, q = e >> 6, d = e & 63; float s = 0.f;
#pragma unroll
        for (int ww = 0; ww < 8; ++ww) s += red[(ww * 16 + q) * 64 + d];
        s *= __builtin_amdgcn_rcpf(wt[16 + q]);
        P.O[(size_t)(MP_ + b * DT_ + q) * 512 + h * 64 + d] = (bf16)f2bf(s); }
    __syncthreads();
}

typedef const __attribute__((address_space(4))) Args* ArgsK;
#define PH_BEGIN() ArgsK A = ap; asm volatile("" : "+s"(A)); int tid = threadIdx.x; asm volatile("" : "+v"(tid)); \
    const int lane = tid & 63, wave = __builtin_amdgcn_readfirstlane(tid >> 6); (void)lane; (void)wave; \
    unsigned char* ws = A->ws; float* out = A->out; (void)out; \
    float* ssb = (float*)(ws + WS_SS); float* cbp = (float*)(ws + WS_CB); bf16* XB = (bf16*)(ws + WS_XB); (void)ssb; (void)cbp; (void)XB; \
    bf16* QO = (bf16*)(ws + WS_ACT); bf16* KB = (bf16*)(ws + WS_ACT + SLOT); bf16* VB = (bf16*)(ws + WS_ACT + 2 * SLOT); bf16* XRB = (bf16*)(ws + WS_ACT + 3 * SLOT); \
    bf16* YGB = (bf16*)(ws + WS_ACT + 4 * SLOT); bf16* LRUO = (bf16*)(ws + WS_ACT + 5 * SLOT); bf16* MIX = (bf16*)(ws + WS_ACT + 6 * SLOT); bf16* HB = (bf16*)(ws + WS_ACT); \
    (void)QO; (void)KB; (void)VB; (void)XRB; (void)YGB; (void)LRUO; (void)MIX; (void)HB; \
    const int gw = bid * 8 + wave, NGW = G * 8; (void)gw; (void)NGW;
#define LAYER_PTRS() bf16* wl = (bf16*)(ws + WS_W + (size_t)l * WS_WL); \
const bf16* win_t = wl; const bf16* wout_t = (const bf16*)((unsigned char*)wl + 6 * MiB); const bf16* wup_t = (const bf16*)((unsigned char*)wl + 8 * MiB); const bf16* wdn_t = (const bf16*)((unsigned char*)wl + 16 * MiB); \
float* kp = out + O_KP + (size_t)l * MP_ * 512; float* vp = out + O_VP + (size_t)l * MP_ * 512; float* lfp = out + O_LFP + (size_t)l * MP_ * 8; \
float* ksm = out + O_KS + (size_t)l * MS_ * 512; float* vsm = out + O_VS + (size_t)l * MS_ * 512; float* lfs = out + O_LFS + (size_t)l * MS_ * 8; \
    (void)win_t; (void)wout_t; (void)wup_t; (void)wdn_t; (void)kp; (void)vp; (void)lfp; (void)ksm; (void)vsm; (void)lfs;
__global__ void __launch_bounds__(512, 2) hymba_fwd(Args args_unused) {
    extern __shared__ __attribute__((aligned(16))) unsigned char lds_raw[];
    cg::grid_group grid = cg::this_grid();
    LAS unsigned char* lds = (LAS unsigned char*)lds_raw;
    const ArgsK ap = (ArgsK)__builtin_amdgcn_kernarg_segment_ptr();
    const int G = gridDim.x, bid = blockIdx.x;
    const int lo = ap->ph_lo, hi = ap->ph_hi;
#define IN(k) (lo <= (k) && (k) < hi)
#define SEAM(k) do { if (IN(k) && IN((k) + 1)) grid.sync(); } while (0)

    if (PK(0) && IN(0)) {
        PH_BEGIN();
        LAS float* scr = (LAS float*)(lds + wave * 16384);
        constexpr int I_IN = 16 * 88, I_OUT = 16 * 32, I_UP = 16 * 128, I_DN = 64 * 32, I_L = I_IN + I_OUT + I_UP + I_DN;
        for (int it = gw; it < 2 * I_L; it += NGW) {
            const int l = it / I_L; int r = it % I_L;
            bf16* wl = (bf16*)(ws + WS_W + (size_t)l * WS_WL);
            if (r < I_IN) { transpose_item<1>(A->in[8] + (size_t)l * 1024 * INW_, 1024, INW_, A->in[7] + l * 1024, nullptr, wl, scr, r / 88, r % 88, lane); continue; } r -= I_IN;
            if (r < I_OUT) { transpose_item<0>(A->in[21] + (size_t)l * 1024 * 1024, 1024, 1024, A->in[19] + l * 512, A->in[20] + l * 512, (bf16*)((unsigned char*)wl + 6 * MiB), scr, r / 32, r % 32, lane); continue; } r -= I_OUT;
            if (r < I_UP) { transpose_item<0>(A->in[23] + (size_t)l * 1024 * 4096, 1024, 4096, A->in[22] + l * 1024, nullptr, (bf16*)((unsigned char*)wl + 8 * MiB), scr, r / 128, r % 128, lane); continue; } r -= I_UP;
            transpose_item<0>(A->in[24] + (size_t)l * 4096 * 1024, 4096, 1024, nullptr, nullptr, (bf16*)((unsigned char*)wl + 16 * MiB), scr, r / 32, r % 32, lane);
        }
        for (int m = gw; m < M_; m += NGW) {
            const float* xr = m < MP_ ? A->in[0] + (size_t)m * 1024 : A->in[1] + (size_t)(m - MP_) * 1024;
            f32x4 v[4]; float s = 0.f;
#pragma unroll
            for (int j = 0; j < 4; ++j) { v[j] = *(const f32x4*)(xr + 256 * j + 4 * lane); s += (v[j][0] * v[j][0] + v[j][1] * v[j][1]) + (v[j][2] * v[j][2] + v[j][3] * v[j][3]); }
            s = wave_sum(s);
#pragma unroll
            for (int j = 0; j < 4; ++j) { v2u o; o.x = pk2(v[j][0], v[j][1]); o.y = pk2(v[j][2], v[j][3]); *(v2u*)(XB + (size_t)m * 1024 + 256 * j + 4 * lane) = o; }
            if (lane == 0) { ssb[m] = s; ssb[M_ + m] = 0.f; ssb[2 * M_ + m] = 0.f; ssb[3 * M_ + m] = 0.f; }
        }
    }
    SEAM(0);

#pragma unroll 1
    for (int l = 0; l < DEPTH_; ++l) {
        const int pb = 1 + 7 * l;
        if (PK(1) && IN(pb)) {
            PH_BEGIN(); LAYER_PTRS();
            pg8::Gemm g{XB, win_t, M_, NIN_, 1024}; pg8::StaticOrder S; S.init(M_, NIN_, G, bid);
            pg8::EpiIn E{QO, out, SLOT / 2, l, ssb + (size_t)l * M_, A->in[10] + l * 64, A->in[11] + l * 64, A->in[9] + l * 8};
            pg8::gemm_phase<pg8::EpiIn, pg8::StaticOrder, true, true, true>(lds, g, S, E);
        }
        SEAM(pb);

        if (PK(2) && IN(pb + 1)) {
            PH_BEGIN(); LAYER_PTRS();
            LayerP P;
            P.conv_w = A->in[12] + l * 2048; P.conv_b = A->in[13] + l * 512; P.wga = A->in[14] + (size_t)l * 32768; P.bga = A->in[15] + l * 512;
            P.wgx = A->in[16] + (size_t)l * 32768; P.bgx = A->in[17] + l * 512; P.lam = A->in[18] + l * 512;
            P.state_h = A->in[5] + (size_t)l * DB_ * 512; P.state_conv = A->in[6] + (size_t)l * DB_ * 3 * 512;
            P.XR = XRB; P.YG = YGB; P.LRUO = LRUO;
            P.h_p = out + O_HP + (size_t)l * NB_ * 512; P.conv_p = out + O_CP + (size_t)l * NB_ * 3 * 512; P.h_s = out + O_HS + (size_t)l * DB_ * 512; P.conv_s = out + O_CS + (size_t)l * DB_ * 3 * 512;
            for (int u = bid; u < 256; u += G) lru_unit(lds, tid, P, u >> 3, u & 7, false);
            for (int u = bid; u < 256; u += G) lru_unit(lds, tid, P, u >> 3, u & 7, true);
            for (int u = bid; u < 256; u += G) cumsum_unit(lds, tid, lfp + (size_t)(u >> 3) * T_ * 8 + (u & 7), cbp + (size_t)u * T_);
        }
        SEAM(pb + 1);

        if (PK(3) && IN(pb + 2)) {
            PH_BEGIN(); LAYER_PTRS();
            if (PK(8)) for (int u = bid; u < 256; u += G) {
#pragma unroll 1
                for (int qb = 7; qb >= 0; --qb)
                    attn_body::attn_unit<8>(u >> 3, u & 7, qb, (const attn_body::bf16*)QO, (const attn_body::bf16*)KB, (const attn_body::bf16*)VB, (attn_body::bf16*)QO, cbp + (size_t)u * T_, (char*)lds_raw);
            }
            SampP SPp{QO, QO, A->in[2] + (size_t)l * DB_ * PAST_ * 512, A->in[3] + (size_t)l * DB_ * PAST_ * 512, A->in[4] + (size_t)l * DB_ * PAST_ * 8, ksm, vsm, lfs};
            if (PK(9)) for (int u = bid; u < 256; u += G) sattn_unit(lds, tid, SPp, u >> 3, u & 7);
        }
        SEAM(pb + 2);

        if (PK(4) && IN(pb + 3)) {
            PH_BEGIN(); LAYER_PTRS();
            for (int m = gw; m < M_; m += NGW) {
                const v4u a = *(const v4u*)(QO + (size_t)m * 512 + 8 * lane), c = *(const v4u*)(LRUO + (size_t)m * 512 + 8 * lane);
                float fa[8], fc[8]; float sa = 0.f, sc = 0.f;
#pragma unroll
                for (int j = 0; j < 4; ++j) { fa[2 * j] = bf2f(a[j] & 0xffffu); fa[2 * j + 1] = bf2f(a[j] >> 16); fc[2 * j] = bf2f(c[j] & 0xffffu); fc[2 * j + 1] = bf2f(c[j] >> 16); }
#pragma unroll
                for (int j = 0; j < 8; ++j) { sa += fa[j] * fa[j]; sc += fc[j] * fc[j]; }
                sa = wave_sum(sa); sc = wave_sum(sc);
                const float ra = 1.0f / sqrtf(sa * (1.0f / 512.0f) + EPS_), rc = 1.0f / sqrtf(sc * (1.0f / 512.0f) + EPS_);
                v4u oa, oc;
#pragma unroll
                for (int j = 0; j < 4; ++j) { oa[j] = pk2(fa[2 * j] * ra, fa[2 * j + 1] * ra); oc[j] = pk2(fc[2 * j] * rc, fc[2 * j + 1] * rc); }
                *(v4u*)(MIX + (size_t)m * 1024 + 8 * lane) = oa; *(v4u*)(MIX + (size_t)m * 1024 + 512 + 8 * lane) = oc;
            }
        }
        SEAM(pb + 3);

        if (PK(5) && IN(pb + 4)) {
            PH_BEGIN(); LAYER_PTRS();
            pg8::Gemm g{MIX, wout_t, M_, 1024, 1024}; pg8::StaticOrder S; S.init(M_, 1024, G, bid);
            pg8::EpiRes E{l == 0 ? A->in[0] : out, l == 0 ? A->in[1] : out + (size_t)MP_ * 1024, out, XB, ssb + (size_t)(2 + l) * M_, 1};
            pg8::gemm_phase<pg8::EpiRes, pg8::StaticOrder, true, true, false>(lds, g, S, E);
        }
        SEAM(pb + 4);

        if (PK(6) && IN(pb + 5)) {
            PH_BEGIN(); LAYER_PTRS();
            pg8::Gemm g{XB, wup_t, M_, FF_, 1024}; pg8::StaticOrder S; S.init(M_, FF_, G, bid);
            pg8::EpiUp E{HB, ssb + (size_t)(2 + l) * M_};
            pg8::gemm_phase<pg8::EpiUp, pg8::StaticOrder, true, true, false>(lds, g, S, E);
        }
        SEAM(pb + 5);

        if (PK(7) && IN(pb + 6)) {
            PH_BEGIN(); LAYER_PTRS();
            pg8::Gemm g{HB, wdn_t, M_, 1024, FF_}; pg8::StaticOrder S; S.init(M_, 1024, G, bid);
            pg8::EpiRes E{out, out + (size_t)MP_ * 1024, out, XB, ssb + (size_t)M_, l == 0 ? 1 : 0};
            pg8::gemm_phase<pg8::EpiRes, pg8::StaticOrder, true, true, false>(lds, g, S, E);
        }
        SEAM(pb + 6);
    }
#undef IN
#undef SEAM
}

extern "C" void kernel_launch(void* const* d_in, const int* in_sizes, int n_in, void* d_out, int out_size, void* d_ws, size_t ws_size, hipStream_t stream) {
    static int grid = 0;
    if (grid == 0) {
        if (n_in != 25 || (size_t)out_size != O_END || ws_size < WS_END) { fprintf(stderr, "kernel_launch: unexpected problem (n_in %d out %d ws %zu need %zu)\n", n_in, out_size, ws_size, (size_t)WS_END); grid = -1; return; }
        int dev = 0, cus = 0, per_cu = 0;
        hipGetDevice(&dev); hipDeviceGetAttribute(&cus, hipDeviceAttributeMultiprocessorCount, dev);
        if (hipFuncSetAttribute((const void*)hymba_fwd, hipFuncAttributeMaxDynamicSharedMemorySize, LDS_BYTES) != hipSuccess) { fprintf(stderr, "kernel_launch: hipFuncSetAttribute failed\n"); (void)hipGetLastError(); }
        if (hipOccupancyMaxActiveBlocksPerMultiprocessor(&per_cu, (const void*)hymba_fwd, 512, LDS_BYTES) != hipSuccess || per_cu < 1) { fprintf(stderr, "kernel_launch: occupancy query says %d\n", per_cu); per_cu = 1; (void)hipGetLastError(); }
        grid = cus * per_cu;
        fprintf(stderr, "kernel_launch: grid %d (cus %d x %d)\n", grid, cus, per_cu);
    }
    if (grid < 0) return;
    Args a{};
    for (int i = 0; i < 25; ++i) a.in[i] = (const float*)d_in[i];
    a.out = (float*)d_out; a.ws = (unsigned char*)d_ws; a.ph_lo = 0; a.ph_hi = NPHASE;
    void* kargs[] = {&a};
    hipError_t e = hipLaunchCooperativeKernel((const void*)hymba_fwd, dim3(grid), dim3(512), kargs, LDS_BYTES, stream);
    if (e != hipSuccess) fprintf(stderr, "kernel_launch: cooperative launch failed: %s (grid %d)\n", hipGetErrorString(e), grid);
}
```

```cpp
#include <hip/hip_runtime.h>
#include <hip/hip_cooperative_groups.h>
#include <hip/hip_bf16.h>
#include <cstdio>
#include <cstdint>
#include <cmath>
namespace cg = cooperative_groups;

constexpr int DM_ = 1024, NB_ = 32, T_ = 2048, DB_ = 32, DT_ = 16, PAST_ = 1024, NH_ = 8, HD_ = 64, AW_ = 512, LW_ = 512, FF_ = 4096, DEPTH_ = 2;
constexpr int MP_ = NB_ * T_;
constexpr int MS_ = DB_ * DT_;
constexpr int M_ = MP_ + MS_;
constexpr int NIN_ = 2816;
constexpr int INW_ = 2568;
constexpr float EPS_ = 1e-6f;
constexpr float LOG2E_ = 1.4426950408889634f;
constexpr float C2_ = 0.125f * 1.4426950408889634f;

namespace pg8 {
#define PG8_LAS __attribute__((address_space(3)))
typedef unsigned short bf16_t;
typedef short bf16x8 __attribute__((ext_vector_type(8)));
typedef float f32x4 __attribute__((ext_vector_type(4)));
typedef unsigned u32x4 __attribute__((ext_vector_type(4)));
constexpr int BM = 256, BK = 64, HALF = 128, HTB = HALF * BK * 2  , STAGE_BYTES = 8 * HTB, NXCD = 8, WGM = 8;

__host__ __device__ __forceinline__ int lds_byte(int r, int c) { const int st = (r >> 4) * 2 + (c >> 5), rr = r & 15, cc = c & 31, ob = rr * 64 + cc * 2; return st * 1024 + (ob ^ (((ob >> 9) & 1) << 5)); }
__host__ __device__ __forceinline__ void stage_rc(int b, int& R, int& C) { const int st = b / 1024, sb = b % 1024, swz = sb ^ (((sb >> 9) & 1) << 5); R = (st >> 1) * 16 + swz / 64; C = (st & 1) * 32 + (swz % 64) / 2; }
__host__ __device__ __forceinline__ int perm32(int rho) { const int n = rho >> 4, i = rho & 15; return 8 * (i >> 2) + 4 * n + (i & 3); }

struct Unit { int pm, pn; };
struct Gemm { const bf16_t* A; const bf16_t* Bt; int M, N, K; };

struct StaticOrder {
    int nM, nN, nwg, G, c;
    __host__ __device__ void init(int M, int N, int G_, int c_) { nM = M / BM; nN = N / BM; nwg = nM * nN; G = G_; c = c_; }
    __host__ __device__ bool next(int i, Unit& u) const {
        const long L = (long)i * G + c; if (L >= nwg) return false;
        int wgid = (int)L; { const int q = nwg / NXCD, r = nwg % NXCD, xcd = wgid % NXCD, off = wgid / NXCD; wgid = (xcd < r ? xcd * (q + 1) : r * (q + 1) + (xcd - r) * q) + off; }
        const int nig = WGM * nN, gid = wgid / nig, fm = gid * WGM, gsz = (nM - fm) < WGM ? (nM - fm) : WGM;
        u.pm = fm + ((wgid % nig) % gsz); u.pn = (wgid % nig) / gsz; return true;
    }
    __device__ __forceinline__ void a_ready(const Unit&) const {}
    __device__ __forceinline__ void done(const Unit&) const {}
};

__device__ __forceinline__ unsigned cvt_pk_bf16(float lo, float hi) { unsigned r; asm volatile("v_cvt_pk_bf16_f32 %0, %1, %2" : "=v"(r) : "v"(lo), "v"(hi)); return r; }

typedef float f32x2 __attribute__((ext_vector_type(2)));
__device__ __forceinline__ float gelu_tanh(float x) {
    const float u = 0.7978845608028654f * (x + 0.044715f * x * x * x);
    const float e = __builtin_amdgcn_exp2f(-2.0f * 1.4426950408889634f * u);
    return x * __builtin_amdgcn_rcpf(1.0f + e);
}
__device__ __forceinline__ float log_sigmoid_f(float z) { return fminf(z, 0.f) - log1pf(__expf(-fabsf(z))); }

struct EpiIn {
    static constexpr bool PERM = true, AFTER_DRAIN = false;
    bf16_t* act; float* out; size_t slot; int l; const float *ss, *qg, *kg, *bfp;
    __device__ __forceinline__ void operator()(const f32x4 (&acc)[2][2][4][2], const Unit& u, int wr, int wc, int fr, int fq) const {
        const int kind = u.pn >> 1;
        const bool samp = u.pm >= (65536 / 256);
        const int colb = (u.pn & 1) * 256 + 64 * wc + 8 * fq;
        f32x4 g[2][2];
#pragma unroll
        for (int bj = 0; bj < 2; ++bj)
#pragma unroll
            for (int n = 0; n < 2; ++n) {
                g[bj][n] = (f32x4){1.f, 1.f, 1.f, 1.f};
                if (kind == 0) g[bj][n] = *(const f32x4*)(qg + 32 * bj + 8 * fq + 4 * n) * (0.125f * 1.4426950408889634f);
                if (kind == 1) g[bj][n] = *(const f32x4*)(kg + 32 * bj + 8 * fq + 4 * n);
            }
        float rsv[2][4];
#pragma unroll
        for (int ai = 0; ai < 2; ++ai)
#pragma unroll
            for (int m = 0; m < 4; ++m) rsv[ai][m] = ss[u.pm * BM + ai * HALF + wr * 64 + m * 16 + fr];
#pragma unroll
        for (int ai = 0; ai < 2; ++ai)
#pragma unroll
            for (int m = 0; m < 4; ++m) {
                const int row = u.pm * BM + ai * HALF + wr * 64 + m * 16 + fr;
                const float rs = __builtin_amdgcn_rsqf(rsv[ai][m] * (1.0f / 1024.0f) + 1e-6f);
                f32x4 v[2][2];
#pragma unroll
                for (int bj = 0; bj < 2; ++bj)
#pragma unroll
                    for (int n = 0; n < 2; ++n) v[bj][n] = acc[ai][bj][m][n] * rs;
                if (kind <= 1) {
                    float s = 0.f;
#pragma unroll
                    for (int bj = 0; bj < 2; ++bj)
#pragma unroll
                        for (int n = 0; n < 2; ++n) { const f32x4 x = v[bj][n]; s += (x[0] * x[0] + x[1] * x[1]) + (x[2] * x[2] + x[3] * x[3]); }
                    s += __shfl_xor(s, 16); s += __shfl_xor(s, 32);
                    const float inv = __builtin_amdgcn_rsqf(s * (1.0f / 64.0f) + 1e-6f);
#pragma unroll
                    for (int bj = 0; bj < 2; ++bj)
#pragma unroll
                        for (int n = 0; n < 2; ++n) v[bj][n] = v[bj][n] * inv * g[bj][n];
                }
                if (kind == 5) {
                    if (wc == 0 && fq == 0) {
                        float* lf = out + (samp ? (size_t)204079104 + (size_t)l * 4096 + (size_t)(row - 65536) * 8 : (size_t)201850880 + (size_t)l * 524288 + (size_t)row * 8);
#pragma unroll
                        for (int n = 0; n < 2; ++n) { const f32x4 b = *(const f32x4*)(bfp + 4 * n); f32x4 o;
#pragma unroll
                            for (int j = 0; j < 4; ++j) o[j] = log_sigmoid_f(v[0][n][j] + b[j]);
                            *(f32x4*)(lf + 4 * n) = o; }
                    }
                } else {
                    if (kind == 4) {
#pragma unroll
                        for (int bj = 0; bj < 2; ++bj)
#pragma unroll
                            for (int n = 0; n < 2; ++n)
#pragma unroll
                                for (int j = 0; j < 4; ++j) v[bj][n][j] = gelu_tanh(v[bj][n][j]);
                    }
                    bf16_t* rowp = act + (size_t)kind * slot + (size_t)row * 512 + colb;
#pragma unroll
                    for (int bj = 0; bj < 2; ++bj) { u32x4 w; w.x = cvt_pk_bf16(v[bj][0][0], v[bj][0][1]); w.y = cvt_pk_bf16(v[bj][0][2], v[bj][0][3]); w.z = cvt_pk_bf16(v[bj][1][0], v[bj][1][1]); w.w = cvt_pk_bf16(v[bj][1][2], v[bj][1][3]);
                        *(u32x4*)(rowp + 32 * bj) = w; }
                    if (kind == 1 || kind == 2) {
                        const size_t ob = samp ? (size_t)203030528 + (size_t)(kind - 1) * 524288 + (size_t)l * 262144 + (size_t)(row - 65536) * 512
                                               : (size_t)67633152 + (size_t)(kind - 1) * 67108864 + (size_t)l * 33554432 + (size_t)row * 512;
                        float* op = out + ob + colb;
#pragma unroll
                        for (int bj = 0; bj < 2; ++bj)
#pragma unroll
                            for (int n = 0; n < 2; ++n) *(f32x4*)(op + 32 * bj + 4 * n) = v[bj][n];
                    }
                }
            }
    }
};

struct EpiRes {
    static constexpr bool PERM = true, AFTER_DRAIN = false;
    const float* xin_p; const float* xin_s; float* yout; bf16_t* xb; float* ssacc; int wb;
    __device__ __forceinline__ void operator()(const f32x4 (&acc)[2][2][4][2], const Unit& u, int wr, int wc, int fr, int fq) const {
        const bool samp = u.pm >= (65536 / 256);
        const int col0 = u.pn * BM + wc * 32 + 8 * fq;
        const float* xbase = samp ? xin_s + (size_t)(u.pm * BM - 65536) * 1024 : xin_p + (size_t)(u.pm * BM) * 1024;
#pragma unroll
        for (int ai = 0; ai < 2; ++ai) {
            f32x4 pre[4][2][2];
#pragma unroll
            for (int m = 0; m < 4; ++m) { const float* xr_ = xbase + (size_t)(ai * HALF + wr * 64 + m * 16 + fr) * 1024 + col0;
#pragma unroll
                for (int bj = 0; bj < 2; ++bj) { pre[m][bj][0] = *(const f32x4*)(xr_ + bj * HALF); pre[m][bj][1] = *(const f32x4*)(xr_ + bj * HALF + 4); } }
#pragma unroll
            for (int m = 0; m < 4; ++m) {
                const int row = u.pm * BM + ai * HALF + wr * 64 + m * 16 + fr;
                float* yr = yout + (size_t)row * 1024;
                float s = 0.f;
#pragma unroll
                for (int bj = 0; bj < 2; ++bj) {
                    const f32x4 x0 = pre[m][bj][0] + acc[ai][bj][m][0];
                    const f32x4 x1 = pre[m][bj][1] + acc[ai][bj][m][1];
                    *(f32x4*)(yr + col0 + bj * HALF) = x0; *(f32x4*)(yr + col0 + bj * HALF + 4) = x1;
                    if (wb) {
                        s += (x0[0] * x0[0] + x0[1] * x0[1]) + (x0[2] * x0[2] + x0[3] * x0[3]) + (x1[0] * x1[0] + x1[1] * x1[1]) + (x1[2] * x1[2] + x1[3] * x1[3]);
                        u32x4 w; w.x = cvt_pk_bf16(x0[0], x0[1]); w.y = cvt_pk_bf16(x0[2], x0[3]); w.z = cvt_pk_bf16(x1[0], x1[1]); w.w = cvt_pk_bf16(x1[2], x1[3]);
                        *(u32x4*)(xb + (size_t)row * 1024 + col0 + bj * HALF) = w;
                    }
                }
                if (wb) { s += __shfl_xor(s, 16); s += __shfl_xor(s, 32); if (fq == 0) atomicAdd(ssacc + row, s); }
            }
            asm volatile("" ::: "memory");
        }
    }
};

struct EpiUp {
    static constexpr bool PERM = true, AFTER_DRAIN = false;
    bf16_t* H; const float* ss;
    __device__ __forceinline__ void operator()(const f32x4 (&acc)[2][2][4][2], const Unit& u, int wr, int wc, int fr, int fq) const {
        const int col0 = u.pn * BM + wc * 32 + 8 * fq;
        float rsv[2][4];
#pragma unroll
        for (int ai = 0; ai < 2; ++ai)
#pragma unroll
            for (int m = 0; m < 4; ++m) rsv[ai][m] = ss[u.pm * BM + ai * HALF + wr * 64 + m * 16 + fr];
#pragma unroll
        for (int ai = 0; ai < 2; ++ai)
#pragma unroll
            for (int m = 0; m < 4; ++m) {
                const int row = u.pm * BM + ai * HALF + wr * 64 + m * 16 + fr;
                const float rs = __builtin_amdgcn_rsqf(rsv[ai][m] * (1.0f / 1024.0f) + 1e-6f);
                bf16_t* hr = H + (size_t)row * 4096 + col0;
#pragma unroll
                for (int bj = 0; bj < 2; ++bj) {
                    f32x4 x0 = acc[ai][bj][m][0] * rs, x1 = acc[ai][bj][m][1] * rs;
#pragma unroll
                    for (int j = 0; j < 4; ++j) { const float a = fmaxf(x0[j], 0.f), b = fmaxf(x1[j], 0.f); x0[j] = a * a; x1[j] = b * b; }
                    u32x4 w; w.x = cvt_pk_bf16(x0[0], x0[1]); w.y = cvt_pk_bf16(x0[2], x0[3]); w.z = cvt_pk_bf16(x1[0], x1[1]); w.w = cvt_pk_bf16(x1[2], x1[3]);
                    *(u32x4*)(hr + bj * HALF) = w;
                }
            }
    }
};

template <class Epi, class Sched, bool ALIGN_EPI = false, bool SP2 = false, bool HEADPERM = false>
__device__ __forceinline__ void gemm_phase(PG8_LAS unsigned char* lds, const Gemm g, const Sched& S, const Epi& E) {
    int tid_l = threadIdx.x; asm volatile("" : "+v"(tid_l)); const int tid = tid_l, wid = __builtin_amdgcn_readfirstlane(tid >> 6), lane = tid & 63, wr = wid >> 2, wc = wid & 3, fr = lane & 15, fq = lane >> 4;
    const int K = g.K, nt = K / BK;
    unsigned voffA[2], voffB[2];
#pragma unroll
    for (int i = 0; i < 2; ++i) { int R, C; stage_rc(tid * 16 + i * 8192, R, C); const int Rb0 = Epi::PERM ? ((R & ~31) + perm32(R & 31)) : R; const int Rb = HEADPERM ? (64 * (Rb0 >> 5) + (Rb0 & 31)) : Rb0;
        voffA[i] = (unsigned)(R * K + C) * 2u; voffB[i] = (unsigned)(Rb * K + C) * 2u; }
    const size_t kstep = (size_t)(BK * 2);
    const size_t hstep = (size_t)HALF * K * 2;
    const size_t tstep = 2 * hstep; const size_t hstepB = HEADPERM ? (size_t)32 * K * 2 : hstep;
    const unsigned ldsw = (unsigned)wid * 1024u;
    const int aoff = lds_byte(wr * 64 + fr, fq * 8), boff = lds_byte(wc * 32 + fr, fq * 8);
#define PG8_SA(b, h) (((b) * 2 + (h)) * HTB)
#define PG8_SB(b, h) ((4 + (b) * 2 + (h)) * HTB)
#define PG8_STAGE(bufoff, gbase, voff) do { _Pragma("unroll") for (int _i = 0; _i < 2; ++_i) \
        __builtin_amdgcn_global_load_lds((const unsigned*)((const char*)(gbase) + (voff)[_i]), (PG8_LAS unsigned*)(lds + (bufoff) + ldsw + _i * 8192), 16, 0, 0); } while (0)
#define PG8_LDA(dst, b, h) do { _Pragma("unroll") for (int m = 0; m < 4; ++m) _Pragma("unroll") for (int k = 0; k < 2; ++k) dst[m][k] = *(const PG8_LAS bf16x8*)(lds + PG8_SA(b, h) + aoff + m * 2048 + k * 1024); } while (0)
#define PG8_LDB(dst, b, h) do { _Pragma("unroll") for (int n = 0; n < 2; ++n) _Pragma("unroll") for (int k = 0; k < 2; ++k) dst[n][k] = *(const PG8_LAS bf16x8*)(lds + PG8_SB(b, h) + boff + n * 2048 + k * 1024); } while (0)
#define PG8_MMA(ai, bj, At, Bt) do { __builtin_amdgcn_s_setprio(1); _Pragma("unroll") for (int m = 0; m < 4; ++m) _Pragma("unroll") for (int n = 0; n < 2; ++n) _Pragma("unroll") for (int k = 0; k < 2; ++k) \
        acc[ai][bj][m][n] = __builtin_amdgcn_mfma_f32_16x16x32_bf16(Bt[n][k], At[m][k], acc[ai][bj][m][n], 0, 0, 0); __builtin_amdgcn_s_setprio(0); } while (0)
#define PG8_WAIT_V(n) asm volatile("s_waitcnt vmcnt(" #n ")" ::: "memory")
#define PG8_WAIT_L(n) asm volatile("s_waitcnt lgkmcnt(" #n ")" ::: "memory")
#define PG8_BAR __builtin_amdgcn_s_barrier()
#define PG8_SCHED __builtin_amdgcn_sched_barrier(0)
    Unit cur, nxt; int ui = 0;
    if (!S.next(0, cur)) return;
    f32x4 acc[2][2][4][2];
#pragma unroll
    for (int a = 0; a < 2; ++a)
#pragma unroll
        for (int b = 0; b < 2; ++b)
#pragma unroll
            for (int m = 0; m < 4; ++m)
#pragma unroll
                for (int n = 0; n < 2; ++n) acc[a][b][m][n] = (f32x4){0.f, 0.f, 0.f, 0.f};
    bf16x8 At[4][2], B0[2][2], B1[2][2];
    const char* cA = (const char*)g.A + (size_t)cur.pm * tstep; const char* cB = (const char*)g.Bt + (size_t)cur.pn * tstep;
    S.a_ready(cur);
    if constexpr (SP2) {
        PG8_STAGE(PG8_SB(0, 0), cB, voffB); PG8_STAGE(PG8_SB(0, 1), cB + hstepB, voffB); PG8_STAGE(PG8_SA(0, 0), cA, voffA); PG8_STAGE(PG8_SA(0, 1), cA + hstep, voffA);
        if (wr == 1) PG8_BAR;
        PG8_WAIT_V(2); PG8_BAR;
        PG8_STAGE(PG8_SB(1, 0), cB + kstep, voffB); PG8_STAGE(PG8_SA(1, 0), cA + kstep, voffA); PG8_STAGE(PG8_SB(1, 1), cB + hstepB + kstep, voffB);
        PG8_WAIT_V(6); PG8_BAR;
    } else {
        PG8_STAGE(PG8_SB(0, 0), cB, voffB); PG8_STAGE(PG8_SA(0, 0), cA, voffA); PG8_STAGE(PG8_SB(0, 1), cB + hstepB, voffB); PG8_STAGE(PG8_SA(0, 1), cA + hstep, voffA);
        if (wr == 1) PG8_BAR;
        PG8_WAIT_V(4); PG8_BAR;
        PG8_STAGE(PG8_SB(1, 0), cB + kstep, voffB); PG8_STAGE(PG8_SA(1, 0), cA + kstep, voffA); PG8_STAGE(PG8_SB(1, 1), cB + hstepB + kstep, voffB);
        PG8_WAIT_V(6); PG8_BAR;
    }
    for (;;) {
        const bool has_next = S.next(ui + 1, nxt);
        const char* nA = has_next ? (const char*)g.A + (size_t)nxt.pm * tstep : cA; const char* nB = has_next ? (const char*)g.Bt + (size_t)nxt.pn * tstep : cB;
        for (int t = 0; t < nt; t += 2) {
            const bool last = (t == nt - 2);
            const char* a1 = cA + (size_t)(t + 1) * kstep;
            const char* a2 = last ? nA : cA + (size_t)(t + 2) * kstep; const char* b2 = last ? nB : cB + (size_t)(t + 2) * kstep;
            const char* a3 = a2 + kstep; const char* b3 = b2 + kstep;
            if (last && has_next) S.a_ready(nxt);
            if constexpr (SP2) {
            PG8_LDB(B0, 0, 0); PG8_LDB(B1, 0, 1); PG8_SCHED; PG8_LDA(At, 0, 0); PG8_STAGE(PG8_SA(1, 1), a1 + hstep, voffA);
            PG8_WAIT_V(8); PG8_WAIT_L(0); PG8_BAR; PG8_MMA(0, 0, At, B0); PG8_MMA(0, 1, At, B1); PG8_BAR; PG8_SCHED;
            PG8_LDA(At, 0, 1); PG8_STAGE(PG8_SB(0, 0), b2, voffB); PG8_STAGE(PG8_SB(0, 1), b2 + hstepB, voffB); PG8_STAGE(PG8_SA(0, 0), a2, voffA);
            PG8_WAIT_V(8); PG8_WAIT_L(0); PG8_BAR; PG8_MMA(1, 0, At, B0); PG8_MMA(1, 1, At, B1); PG8_BAR; PG8_SCHED;
            PG8_LDB(B0, 1, 0); PG8_LDB(B1, 1, 1); PG8_SCHED; PG8_LDA(At, 1, 0); PG8_STAGE(PG8_SA(0, 1), a2 + hstep, voffA);
            PG8_WAIT_V(8); PG8_WAIT_L(0); PG8_BAR; PG8_MMA(0, 0, At, B0); PG8_MMA(0, 1, At, B1); PG8_BAR; PG8_SCHED;
            PG8_LDA(At, 1, 1); PG8_STAGE(PG8_SB(1, 0), b3, voffB); PG8_STAGE(PG8_SB(1, 1), b3 + hstepB, voffB); PG8_STAGE(PG8_SA(1, 0), a3, voffA);
            PG8_WAIT_V(8); PG8_WAIT_L(0); PG8_BAR; PG8_MMA(1, 0, At, B0); PG8_MMA(1, 1, At, B1); PG8_BAR; PG8_SCHED;
            } else {
            PG8_LDB(B0, 0, 0); PG8_SCHED; PG8_LDA(At, 0, 0); PG8_STAGE(PG8_SA(1, 1), a1 + hstep, voffA);
            PG8_WAIT_L(8); PG8_BAR; PG8_WAIT_L(0); PG8_MMA(0, 0, At, B0); PG8_BAR; PG8_SCHED;
            PG8_LDB(B1, 0, 1); PG8_STAGE(PG8_SB(0, 0), b2, voffB);
            PG8_BAR; PG8_WAIT_L(0); PG8_MMA(0, 1, At, B1); PG8_BAR;
            PG8_LDA(At, 0, 1); PG8_STAGE(PG8_SA(0, 0), a2, voffA);
            PG8_BAR; PG8_WAIT_L(0); PG8_MMA(1, 0, At, B0); PG8_BAR; PG8_SCHED;
            PG8_STAGE(PG8_SB(0, 1), b2 + hstepB, voffB);
            PG8_WAIT_V(6); PG8_BAR; PG8_MMA(1, 1, At, B1); PG8_BAR;
            PG8_LDB(B0, 1, 0); PG8_SCHED; PG8_LDA(At, 1, 0); PG8_STAGE(PG8_SA(0, 1), a2 + hstep, voffA);
            PG8_WAIT_L(8); PG8_BAR; PG8_WAIT_L(0); PG8_MMA(0, 0, At, B0); PG8_BAR; PG8_SCHED;
            PG8_LDB(B1, 1, 1); PG8_STAGE(PG8_SB(1, 0), b3, voffB);
            PG8_BAR; PG8_WAIT_L(0); PG8_MMA(0, 1, At, B1); PG8_BAR;
            PG8_LDA(At, 1, 1); PG8_STAGE(PG8_SA(1, 0), a3, voffA);
            PG8_BAR; PG8_WAIT_L(0); PG8_MMA(1, 0, At, B0); PG8_BAR; PG8_SCHED;
            PG8_STAGE(PG8_SB(1, 1), b3 + hstepB, voffB);
            PG8_WAIT_V(6); PG8_BAR; PG8_MMA(1, 1, At, B1); PG8_BAR;
            }
        }
        if constexpr (ALIGN_EPI) { if (wr == 0) PG8_BAR; }
        if constexpr (!Epi::AFTER_DRAIN) { E(acc, cur, wr, wc, fr, fq); S.done(cur); }
        if (!has_next) break;
#pragma unroll
        for (int a = 0; a < 2; ++a)
#pragma unroll
            for (int b = 0; b < 2; ++b)
#pragma unroll
                for (int m = 0; m < 4; ++m)
#pragma unroll
                    for (int n = 0; n < 2; ++n) acc[a][b][m][n] = (f32x4){0.f, 0.f, 0.f, 0.f};
        cur = nxt; cA = nA; cB = nB; ++ui;
        if constexpr (ALIGN_EPI) { if (wr == 1) PG8_BAR; }
    }
    PG8_WAIT_V(0);
    if constexpr (!ALIGN_EPI) { if (wr == 0) PG8_BAR; }
    PG8_BAR;
    if constexpr (Epi::AFTER_DRAIN) { E.fused(acc, cur, wr, wc, fr, fq, lds, wid, lane); S.done(cur); }
#undef PG8_SA
#undef PG8_SB
#undef PG8_STAGE
#undef PG8_LDA
#undef PG8_LDB
#undef PG8_MMA
#undef PG8_WAIT_V
#undef PG8_WAIT_L
#undef PG8_BAR
#undef PG8_SCHED
}
}

#include <hip/hip_bf16.h>
#include <cmath>
namespace attn_body {
using bf16=__hip_bfloat16;
using bf16x8=__attribute__((ext_vector_type(8)))short;
using s16x4=__attribute__((ext_vector_type(4)))short;
using f32x16=__attribute__((ext_vector_type(16)))float;
using u32x4=__attribute__((ext_vector_type(4)))unsigned;
constexpr int BATCH=32,NHEAD=8,SEQ=2048,D=64,DM=NHEAD*D;
constexpr int NW=8,QBLK=32,QB=QBLK*NW,KVBLK=64,NQB=SEQ/QB;
constexpr int ATTN_PITCH=DM, ATTN_UNIT_ROWS=QB;
__device__ __forceinline__ int crow(int r,int hi){return (r&3)+8*(r>>2)+4*hi;}
#define SBAR() __builtin_amdgcn_sched_barrier(0)
__device__ __forceinline__ void cmask(f32x16&p0,f32x16&p1,int jb,int qrel,int hi){
  const float NEG=-INFINITY; int kb=64*jb+4*hi;
  #pragma unroll
  for(int r=0;r<16;++r){int kv=kb+(r&3)+8*(r>>2); if(kv>qrel)p0[r]=NEG; if(kv+32>qrel)p1[r]=NEG;}
}

constexpr int NSLOT=3, SLOTB=8192;
constexpr int LDS_K=0, LDS_V=NSLOT*SLOTB, LDS_WS=2*NSLOT*SLOTB, LDS_OST=LDS_WS+NW*64*4, LDS_CB=LDS_OST+NW*4096, LDS_BYTES=LDS_CB+SEQ*4;
constexpr float C2=0.125f*1.4426950408889634f;
__device__ __forceinline__ void glds16(const void*gsrc,unsigned lds_dst){unsigned keep;
  asm volatile("s_mov_b32 %0, m0\n\ts_mov_b32 m0, %2\n\ts_nop 0\n\tglobal_load_lds_dwordx4 %1, off\n\ts_mov_b32 m0, %0":"=&s"(keep):"v"(gsrc),"s"(lds_dst):"memory");}
__device__ __forceinline__ float max3f(float a,float b,float c){float r;asm("v_max3_f32 %0, %1, %2, %3":"=v"(r):"v"(a),"v"(b),"v"(c));return r;}
__device__ __forceinline__ float max2f(float a,float b){float r;asm("v_max_f32_e32 %0, %1, %2":"=v"(r):"v"(a),"v"(b));return r;}
__device__ __forceinline__ float fadd_s(float a,float b){float r;asm("v_add_f32_e32 %0, %1, %2":"=v"(r):"v"(a),"v"(b));return r;}
__device__ __forceinline__ float fsub_s(float a,float b){float r;asm("v_sub_f32_e32 %0, %1, %2":"=v"(r):"v"(a),"v"(b));return r;}
typedef float f32x2_t __attribute__((ext_vector_type(2))); typedef __bf16 bf16x2_t __attribute__((ext_vector_type(2)));
__device__ __forceinline__ unsigned cvtpk_s(float lo,float hi){f32x2_t v={lo,hi};bf16x2_t b=__builtin_convertvector(v,bf16x2_t);return __builtin_bit_cast(unsigned,b);}
#define WAIT_BAR(N) asm volatile("s_waitcnt vmcnt(" #N ") lgkmcnt(0)\n\ts_barrier":::"memory")

__device__ __forceinline__ void qkt(f32x16&p0,f32x16&p1,const char*Kslot,const bf16x8*qr,int r32,int hi){
  const char*kb=Kslot+hi*1024+r32*16;
  #pragma unroll
  for(int d0=0;d0<4;++d0){
    const bf16x8 b0=*reinterpret_cast<const bf16x8*>(kb+d0*2048);
    const bf16x8 b1=*reinterpret_cast<const bf16x8*>(kb+d0*2048+512);
    {p0=__builtin_amdgcn_mfma_f32_32x32x16_bf16(b0,qr[d0],p0,0,0,0);p1=__builtin_amdgcn_mfma_f32_32x32x16_bf16(b1,qr[d0],p1,0,0,0);}}
}
typedef __attribute__((address_space(3))) const char* lds_cptr;
typedef float f32x4_t __attribute__((ext_vector_type(4)));
typedef __attribute__((address_space(3))) const f32x4_t* lds_f4p;
typedef short v4i16_t __attribute__((ext_vector_type(4)));
__device__ __forceinline__ void kload8(bf16x8*kf,lds_cptr kp){
  kf[0]=*(const __attribute__((address_space(3))) bf16x8*)(kp);      kf[1]=*(const __attribute__((address_space(3))) bf16x8*)(kp+512);
  kf[2]=*(const __attribute__((address_space(3))) bf16x8*)(kp+2048); kf[3]=*(const __attribute__((address_space(3))) bf16x8*)(kp+2560);
  kf[4]=*(const __attribute__((address_space(3))) bf16x8*)(kp+4096); kf[5]=*(const __attribute__((address_space(3))) bf16x8*)(kp+4608);
  kf[6]=*(const __attribute__((address_space(3))) bf16x8*)(kp+6144); kf[7]=*(const __attribute__((address_space(3))) bf16x8*)(kp+6656);
}
__device__ __forceinline__ void kload2(bf16x8*kf,lds_cptr kp,int j){ kf[2*j]=*(const __attribute__((address_space(3))) bf16x8*)(kp+j*2048); kf[2*j+1]=*(const __attribute__((address_space(3))) bf16x8*)(kp+j*2048+512); }
__device__ __forceinline__ s16x4 vtr(lds_cptr p){ return __builtin_bit_cast(s16x4,__builtin_amdgcn_ds_read_tr16_b64_v4i16((__attribute__((address_space(3))) v4i16_t*)p)); }
__device__ __forceinline__ float rowmax(const f32x16&p0,const f32x16&p1){
  float a=max3f(p0[0],p0[1],p1[0]),b=max3f(p0[2],p0[3],p1[1]);a=max3f(a,p1[2],p1[3]);
  #pragma unroll
  for(int r=4;r<16;r+=4){a=max3f(a,p0[r],p0[r+1]);b=max3f(b,p0[r+2],p0[r+3]);a=max3f(a,p1[r],p1[r+1]);b=max3f(b,p1[r+2],p1[r+3]);}
  const float m=max2f(a,b);
  auto rr=__builtin_amdgcn_permlane32_swap(__float_as_uint(m),__float_as_uint(m),false,false);
  return max2f(__uint_as_float(rr[0]),__uint_as_float(rr[1]));
}
__device__ __forceinline__ void pv(f32x16*o,int vb,bf16x8 pa0,bf16x8 pa1,bf16x8 pa2,bf16x8 pa3){
  #pragma unroll
  for(int d0=0;d0<2;++d0){s16x4 lo[4],hi[4];
    #pragma unroll
    for(int ks=0;ks<4;++ks){
      asm volatile("ds_read_b64_tr_b16 %0,%1 offset:%c2":"=&v"(lo[ks]):"v"(vb),"i"(d0*4096+ks*1024):"memory");
      asm volatile("ds_read_b64_tr_b16 %0,%1 offset:%c2":"=&v"(hi[ks]):"v"(vb),"i"(d0*4096+ks*1024+512):"memory");}
    asm volatile("s_waitcnt lgkmcnt(0)":::"memory");SBAR();
    #define PK(k) (bf16x8){lo[k][0],lo[k][1],lo[k][2],lo[k][3],hi[k][0],hi[k][1],hi[k][2],hi[k][3]}
    o[d0]=__builtin_amdgcn_mfma_f32_32x32x16_bf16(pa0,PK(0),o[d0],0,0,0);
    o[d0]=__builtin_amdgcn_mfma_f32_32x32x16_bf16(pa1,PK(1),o[d0],0,0,0);
    o[d0]=__builtin_amdgcn_mfma_f32_32x32x16_bf16(pa2,PK(2),o[d0],0,0,0);
    o[d0]=__builtin_amdgcn_mfma_f32_32x32x16_bf16(pa3,PK(3),o[d0],0,0,0);
    #undef PK
  }
}

#ifndef ATTN_STORE16
#define ATTN_STORE16(p,v) (*(u32x4*)(p)=(v))
#endif
template<int THRL> __device__ __forceinline__ void attn_unit(int b,int h,int qb,const bf16*Q,const bf16*__restrict__ K,const bf16*__restrict__ V,bf16*O,const float*cbg,char*shm){
  int tid_l=threadIdx.x; asm volatile("":"+v"(tid_l)); const int tid=tid_l,lane=tid&63,r32=lane&31,hi=lane>>5; const int wid=__builtin_amdgcn_readfirstlane(tid>>6);
  const long rowbase=(long)b*SEQ; const int q0=qb*QB;
  const bf16*Qw=Q+(rowbase+q0+wid*QBLK)*DM+h*D;
  const bf16*Kh=K+rowbase*DM+h*D,*Vh=V+rowbase*DM+h*D;
  const unsigned lds0=(unsigned)(uintptr_t)shm;
  float*wsf=(float*)(shm+LDS_WS)+wid*64;
  const bf16*ksrc=Kh+(long)lane*DM+wid*8;
  const bf16*vsrc=Vh+(long)(16*(wid&3)+(lane>>2))*DM+(wid>>2)*32+(lane&3)*8;
  const unsigned kdst=lds0+LDS_K+wid*1024, vdst=lds0+LDS_V+wid*1024;
  #define DMA_K(t,slot) glds16(ksrc+(long)(t)*KVBLK*DM,(unsigned)__builtin_amdgcn_readfirstlane(kdst+(slot)))
  #define DMA_V(t,slot) glds16(vsrc+(long)(t)*KVBLK*DM,(unsigned)__builtin_amdgcn_readfirstlane(vdst+(slot)))
  const int vb0=(int)(lds0+LDS_V)+((lane>>4)&1)*32+(lane&3)*8+(4*hi+((lane&15)>>2))*64;
  const char*Kbase=shm+LDS_K; bf16x8 kf[8];
  const lds_cptr shm3=(lds_cptr)shm; const lds_cptr kp0=shm3+LDS_K+hi*1024+r32*16; const lds_cptr vp0=shm3+LDS_V+((lane>>4)&1)*32+(lane&3)*8+(4*hi+((lane&15)>>2))*64;
  const int NT=(q0+QB)/KVBLK;
  { const f32x4_t cv_=*reinterpret_cast<const f32x4_t*>(cbg+4*tid); *(__attribute__((address_space(3))) f32x4_t*)((lds_cptr)shm+LDS_CB+16*tid)=cv_; }
  const lds_f4p cb4=(lds_f4p)((lds_cptr)shm+LDS_CB);
  #define BINIT(P0,P1,t) do{ const lds_f4p bp_=cb4+((t)*16+hi); _Pragma("unroll") for(int g_=0;g_<4;++g_){ const f32x4_t b0_=bp_[2*g_], b1_=bp_[2*g_+8]; \
      P0[4*g_]=b0_[0]-mhat; P0[4*g_+1]=b0_[1]-mhat; P0[4*g_+2]=b0_[2]-mhat; P0[4*g_+3]=b0_[3]-mhat; \
      P1[4*g_]=b1_[0]-mhat; P1[4*g_+1]=b1_[1]-mhat; P1[4*g_+2]=b1_[2]-mhat; P1[4*g_+3]=b1_[3]-mhat; } }while(0)
  DMA_K(0,0);DMA_V(0,0);DMA_K(1,SLOTB);
  bf16x8 qr[4];
  #pragma unroll
  for(int d0=0;d0<4;++d0)qr[d0]=*reinterpret_cast<const bf16x8*>(&Qw[(long)r32*DM+d0*16+hi*8]);
  float mhat=0.f,l_reg=0.f;f32x16 o[2];o[0]=f32x16{};o[1]=f32x16{};
  const int qrel=wid*QBLK+r32;
  #define CMASK(P0,P1,t) do{int jb_=(t)-(NT-4); if(jb_>=0)cmask(P0,P1,jb_,qrel,hi);}while(0)
  bool resc=false;
  #define START(P0,P1) do{ const float rm=rowmax(P0,P1); resc=false; \
    { const float dl=rm; mhat=fadd_s(mhat,dl); \
      _Pragma("unroll") for(int r=0;r<16;++r){P0[r]=fsub_s(P0[r],dl);P1[r]=fsub_s(P1[r],dl);} \
      } \
    _Pragma("unroll") for(int r=0;r<16;++r)P0[r]=__builtin_amdgcn_exp2f(P0[r]); }while(0)
  #define RESC() do{ if(resc){ asm volatile("s_waitcnt lgkmcnt(0)":::"memory"); \
      _Pragma("unroll") for(int d_=0;d_<2;++d_) _Pragma("unroll") for(int r=0;r<16;++r)o[d_][r]*=wsf[crow(r,hi)]; } }while(0)
  f32x16 pA0,pA1,pB0,pB1;
  int sl_prev=0,sl_cur=0,sl_next=SLOTB;
  #define ROT() do{sl_prev=sl_cur;sl_cur=sl_next;sl_next=(sl_next==(NSLOT-1)*SLOTB)?0:sl_next+SLOTB;}while(0)
  DMA_K(2,2*SLOTB);
  WAIT_BAR(3);
  BINIT(pA0,pA1,0); qkt(pA0,pA1,Kbase,qr,r32,hi);asm volatile("s_nop 15\n\ts_nop 7":"+v"(pA0),"+v"(pA1));CMASK(pA0,pA1,0);
  START(pA0,pA1);
  _Pragma("unroll") for(int r=0;r<16;++r)pA1[r]=__builtin_amdgcn_exp2f(pA1[r]);
  WAIT_BAR(0);
  DMA_K(3,0);DMA_V(1,SLOTB);
  ROT();
  kload8(kf,kp0+sl_cur);
  WAIT_BAR(2);
  s16x4 vlo[8],vhi[8]; u32x4 pw0,pw1,pw2,pw3;
  #define PKW(P,B) cvtpk_s(P[B],P[B+1])
  #define PAF(k) __builtin_bit_cast(bf16x8,pw##k)
  #define VFR(i) (bf16x8){vlo[i][0],vlo[i][1],vlo[i][2],vlo[i][3],vhi[i][0],vhi[i][1],vhi[i][2],vhi[i][3]}
  #define PIN(x) asm volatile("":"+v"(x))
  #define MX3(a,b,c) __builtin_fmaxf(__builtin_fmaxf((a),(b)),(c))
  #define GAPA(MF,A0,A1,A2,A3,W0,W1,PW) do{ MF; sacc+=A0; sacc+=A1; sacc+=A2; sacc+=A3; PIN(sacc); W0; W1; PIN(PW); SBAR(); }while(0)
  #define EX(v) __builtin_amdgcn_exp2f(v)
  #define GAPB(MF,X,B) do{ MF; X[B]=EX(X[B]); X[B+1]=EX(X[B+1]); X[B+2]=EX(X[B+2]); X[B+3]=EX(X[B+3]); PIN(X); SBAR(); }while(0)
  #define VRD(i) do{ vlo[i]=vtr(vp_+(((i)>>2)*4096+((i)&3)*1024)); vhi[i]=vtr(vp_+(((i)>>2)*4096+((i)&3)*1024+512)); }while(0)
  #define KRD(G,j) do{ if(G){ kload2(kf,kp0+sl_next,j); SBAR(); } }while(0)
  #define STEP(C0,C1,P0,P1,t,GK,GV,GL) do{ BINIT(C0,C1,t); SBAR(); \
    const lds_cptr vp_=vp0+sl_prev; \
    VRD(0); SBAR(); float sacc=(P0[0]+P0[1]); \
    GAPA(C0=__builtin_amdgcn_mfma_f32_32x32x16_bf16(kf[0],qr[0],C0,0,0,0), P0[2],P0[3],P0[4],P0[5],     pw0[0]=PKW(P0,0), pw0[1]=PKW(P0,2), pw0); \
    VRD(4); SBAR(); GAPA(C1=__builtin_amdgcn_mfma_f32_32x32x16_bf16(kf[1],qr[0],C1,0,0,0), P0[6],P0[7],P0[8],P0[9],     pw0[2]=PKW(P0,4), pw0[3]=PKW(P0,6), pw0); \
    VRD(1); SBAR(); GAPA(C0=__builtin_amdgcn_mfma_f32_32x32x16_bf16(kf[2],qr[1],C0,0,0,0),   P0[10],P0[11],P0[12],P0[13], pw1[0]=PKW(P0,8), pw1[1]=PKW(P0,10), pw1); \
    VRD(5); SBAR(); GAPA(C1=__builtin_amdgcn_mfma_f32_32x32x16_bf16(kf[3],qr[1],C1,0,0,0),   P0[14],P0[15],P1[0],P1[1],   pw1[2]=PKW(P0,12),pw1[3]=PKW(P0,14), pw1); \
    VRD(2); SBAR(); GAPA(C0=__builtin_amdgcn_mfma_f32_32x32x16_bf16(kf[4],qr[2],C0,0,0,0),   P1[2],P1[3],P1[4],P1[5],     pw2[0]=PKW(P1,0), pw2[1]=PKW(P1,2), pw2); \
    VRD(6); SBAR(); GAPA(C1=__builtin_amdgcn_mfma_f32_32x32x16_bf16(kf[5],qr[2],C1,0,0,0),   P1[6],P1[7],P1[8],P1[9],     pw2[2]=PKW(P1,4), pw2[3]=PKW(P1,6), pw2); \
    VRD(3); SBAR(); GAPA(C0=__builtin_amdgcn_mfma_f32_32x32x16_bf16(kf[6],qr[3],C0,0,0,0),   P1[10],P1[11],P1[12],P1[13], pw3[0]=PKW(P1,8), pw3[1]=PKW(P1,10), pw3); \
    VRD(7); SBAR(); GAPA(C1=__builtin_amdgcn_mfma_f32_32x32x16_bf16(kf[7],qr[3],C1,0,0,0),   P1[14],P1[15],0.f,0.f,       pw3[2]=PKW(P1,12),pw3[3]=PKW(P1,14), pw3); \
    l_reg+=sacc; \
    if(GK){DMA_K((t)+3,sl_cur);} if(GV){DMA_V((t)+1,sl_next);} \
    CMASK(C0,C1,t); \
    { float a=MX3(C0[0],C0[1],C1[0]),b=MX3(C0[2],C0[3],C1[1]); a=MX3(a,C1[2],C1[3]); \
      _Pragma("unroll") for(int r=4;r<16;r+=4){a=MX3(a,C0[r],C0[r+1]);b=MX3(b,C0[r+2],C0[r+3]);a=MX3(a,C1[r],C1[r+1]);b=MX3(b,C1[r+2],C1[r+3]);} \
      float rm=__builtin_fmaxf(a,b); { auto rr=__builtin_amdgcn_permlane32_swap(__float_as_uint(rm),__float_as_uint(rm),false,false); rm=__builtin_fmaxf(__uint_as_float(rr[0]),__uint_as_float(rr[1])); } \
      resc=false; \
      if(__builtin_expect(__any(rm>(float)THRL),0)){ const float dl=__builtin_fmaxf(rm,0.f); mhat+=dl; \
        _Pragma("unroll") for(int r=0;r<16;++r){C0[r]-=dl;C1[r]-=dl;} \
        const float f=__builtin_amdgcn_exp2f(-dl); l_reg*=f; if(hi==0)wsf[r32]=f; resc=true; } } \
    SBAR(); \
    GAPB(o[0]=__builtin_amdgcn_mfma_f32_32x32x16_bf16(PAF(0),VFR(0),o[0],0,0,0), C0,0); \
    GAPB(o[1]=__builtin_amdgcn_mfma_f32_32x32x16_bf16(PAF(0),VFR(4),o[1],0,0,0), C0,4); \
    KRD(GL,0); GAPB(o[0]=__builtin_amdgcn_mfma_f32_32x32x16_bf16(PAF(1),VFR(1),o[0],0,0,0), C0,8); \
    KRD(GL,1); GAPB(o[1]=__builtin_amdgcn_mfma_f32_32x32x16_bf16(PAF(1),VFR(5),o[1],0,0,0), C0,12); \
    KRD(GL,2); GAPB(o[0]=__builtin_amdgcn_mfma_f32_32x32x16_bf16(PAF(2),VFR(2),o[0],0,0,0), C1,0); \
    KRD(GL,3); GAPB(o[1]=__builtin_amdgcn_mfma_f32_32x32x16_bf16(PAF(2),VFR(6),o[1],0,0,0), C1,4); \
    GAPB(o[0]=__builtin_amdgcn_mfma_f32_32x32x16_bf16(PAF(3),VFR(3),o[0],0,0,0), C1,8); \
    GAPB(o[1]=__builtin_amdgcn_mfma_f32_32x32x16_bf16(PAF(3),VFR(7),o[1],0,0,0), C1,12); \
    }while(0)
  int t=1;
  #undef CMASK
  #define CMASK(P0,P1,t) do{}while(0)
  for(;t+5<NT;t+=2){
    STEP(pB0,pB1,pA0,pA1,t,true,true,true);     WAIT_BAR(2); RESC(); ROT();
    STEP(pA0,pA1,pB0,pB1,t+1,true,true,true);   WAIT_BAR(2); RESC(); ROT();
  }
  #undef CMASK
  #define CMASK(P0,P1,t) do{int jb_=(t)-(NT-4); if(jb_>=0)cmask(P0,P1,jb_,qrel,hi);}while(0)
  #define ENDW(tt) do{ if((tt)+3<NT){WAIT_BAR(2);} else if((tt)+2<NT){WAIT_BAR(1);} else {WAIT_BAR(0);} }while(0)
  for(;t+1<NT;t+=2){
    STEP(pB0,pB1,pA0,pA1,t,(t+3<NT),(t+1<NT),(t+1<NT));       ENDW(t);   RESC(); ROT();
    STEP(pA0,pA1,pB0,pB1,t+1,(t+4<NT),(t+2<NT),(t+2<NT));     ENDW(t+1); RESC(); ROT();
  }
  STEP(pB0,pB1,pA0,pA1,NT-1,false,false,false); RESC();
  { float sacc=pB0[0]+pB0[1]; _Pragma("unroll") for(int r=2;r<16;++r)sacc+=pB0[r]; _Pragma("unroll") for(int r=0;r<16;++r)sacc+=pB1[r]; l_reg+=sacc;
    pw0=(u32x4){PKW(pB0,0),PKW(pB0,2),PKW(pB0,4),PKW(pB0,6)};pw1=(u32x4){PKW(pB0,8),PKW(pB0,10),PKW(pB0,12),PKW(pB0,14)};pw2=(u32x4){PKW(pB1,0),PKW(pB1,2),PKW(pB1,4),PKW(pB1,6)};pw3=(u32x4){PKW(pB1,8),PKW(pB1,10),PKW(pB1,12),PKW(pB1,14)};
    SBAR(); pv(o,vb0+sl_cur,PAF(0),PAF(1),PAF(2),PAF(3)); }
  #undef PKW
  #undef PAF
  #undef VFR
  #undef PIN
  #undef MX3
  #undef GAPA
  #undef GAPB
  #undef EX
  #undef VRD
  #undef KRD
  #undef STEP
  #undef ENDW
  {auto rr=__builtin_amdgcn_permlane32_swap(__float_as_uint(l_reg),__float_as_uint(l_reg),false,false);l_reg=__uint_as_float(rr[0])+__uint_as_float(rr[1]);}
  if(hi==0)wsf[32+r32]=l_reg;asm volatile("s_waitcnt lgkmcnt(0)":::"memory");
  float rli[16];
  #pragma unroll
  for(int r=0;r<16;++r)rli[r]=__builtin_amdgcn_rcpf(wsf[32+crow(r,hi)]);
  bf16*Ow=O+(rowbase+q0+wid*QBLK)*DM+h*D;
  { bf16*stg=(bf16*)(shm+LDS_OST)+wid*2048;
    #pragma unroll
    for(int r=0;r<16;++r){const int orow=crow(r,hi);
      #pragma unroll
      for(int d0=0;d0<2;++d0)stg[orow*64+d0*32+r32]=__float2bfloat16(o[d0][r]*rli[r]);}
    asm volatile("s_waitcnt lgkmcnt(0)":::"memory");
    #pragma unroll
    for(int i=0;i<4;++i){const int row=i*8+(lane>>3),ch=lane&7; const u32x4 v=*(const u32x4*)(stg+row*64+ch*8); ATTN_STORE16(Ow+(long)row*DM+ch*8,v);} }
  asm volatile("s_waitcnt lgkmcnt(0)\n\ts_barrier":::"memory");
  #undef BINIT
  #undef DMA_K
  #undef DMA_V
  #undef CMASK
  #undef START
  #undef RESC
  #undef ROT
}
constexpr int ATTN_LDS_BYTES=LDS_BYTES;
#undef SBAR
#undef WAIT_BAR
}

#define LAS __attribute__((address_space(3)))
typedef unsigned short bf16;
typedef unsigned v4u __attribute__((ext_vector_type(4)));
typedef unsigned v2u __attribute__((ext_vector_type(2)));
typedef float f32x4 __attribute__((ext_vector_type(4)));
typedef short bf16x8 __attribute__((ext_vector_type(8)));
__device__ __forceinline__ unsigned f2bf(float f) { unsigned u = __builtin_bit_cast(unsigned, f); return (u + 0x7fffu + ((u >> 16) & 1u)) >> 16; }
__device__ __forceinline__ unsigned pk2(float lo, float hi) { return f2bf(lo) | (f2bf(hi) << 16); }
__device__ __forceinline__ float bf2f(unsigned b) { return __uint_as_float(b << 16); }
__device__ __forceinline__ float wave_sum(float v) {
#pragma unroll
    for (int o = 1; o < 64; o <<= 1) v += __shfl_xor(v, o);
    return v;
}
__device__ __forceinline__ float wave_max(float v) {
#pragma unroll
    for (int o = 1; o < 64; o <<= 1) v = fmaxf(v, __shfl_xor(v, o));
    return v;
}
__device__ __forceinline__ float sigm(float z) { return __builtin_amdgcn_rcpf(1.0f + __builtin_amdgcn_exp2f(-1.4426950408889634f * z)); }

constexpr size_t MiB = 1u << 20;
constexpr size_t WS_SS = 1 * MiB, WS_CB = 3 * MiB, WS_W = 8 * MiB, WS_WL = 24 * MiB, WS_XB = 64 * MiB, WS_ACT = 200 * MiB;
constexpr size_t SLOT = (size_t)M_ * 512 * 2;
constexpr size_t WS_END = WS_ACT + 8 * SLOT;
constexpr int LDS_BYTES = 147456;
constexpr int NPHASE = 15;
#ifndef PHMASK
#define PHMASK 0x3ff
#endif
#define PK(j) (((PHMASK) >> (j)) & 1)

constexpr size_t O_Y = 0, O_KP = 67633152, O_VP = 134742016, O_LFP = 201850880, O_HP = 202899456, O_CP = 202932224,
                 O_KS = 203030528, O_VS = 203554816, O_LFS = 204079104, O_HS = 204087296, O_CS = 204120064, O_END = 204218368;

struct Args { const float* in[25]; float* out; unsigned char* ws; int ph_lo, ph_hi; };

template <int MODE>
__device__ __forceinline__ void transpose_item(const float* W, int K, int Nsrc, const float* gain, const float* gain2, bf16* WT, LAS float* scr, int kb, int nb, int lane) {
    const int k0 = 64 * kb, n0 = 32 * nb;
    int sc = n0 + (lane & 31);
    if (MODE == 1) { const int r = sc; sc = r < 1536 ? r : (r < 2560 ? r + 8 : (r < 2568 ? r - 1024 : -1)); }
#pragma unroll 8
    for (int i = 0; i < 32; ++i) { const int kk = 2 * i + (lane >> 5); const int k = k0 + kk;
        float gsc = 1.f; if (gain) gsc = (gain2 && k >= 512) ? gain2[k - 512] : gain[k];
        scr[kk * 33 + (lane & 31)] = sc >= 0 ? W[(size_t)k * Nsrc + sc] * gsc : 0.f; }
    asm volatile("s_waitcnt lgkmcnt(0)" ::: "memory");
    const int c = lane & 7;
#pragma unroll
    for (int j = 0; j < 4; ++j) { const int n = (lane >> 3) + 8 * j; const LAS float* s = scr + (8 * c) * 33 + n;
        v4u o; o.x = pk2(s[0 * 33], s[1 * 33]); o.y = pk2(s[2 * 33], s[3 * 33]); o.z = pk2(s[4 * 33], s[5 * 33]); o.w = pk2(s[6 * 33], s[7 * 33]);
        *(v4u*)(WT + (size_t)(n0 + n) * K + k0 + 8 * c) = o; }
    asm volatile("s_waitcnt lgkmcnt(0)" ::: "memory");
}

struct LayerP {
    const float *conv_w, *conv_b, *wga, *bga, *wgx, *bgx, *lam, *state_h, *state_conv;
    const bf16 *XR, *YG; bf16* LRUO;
    float *h_p, *conv_p, *h_s, *conv_s;
};

__device__ __forceinline__ unsigned cvt1bf(float v) { unsigned r; asm volatile("v_cvt_pk_bf16_f32 %0, %1, %1" : "=v"(r) : "v"(v)); return r; }
__device__ __forceinline__ void lru_unit(LAS unsigned char* lds, const int tid, const LayerP& P, const int b, const int n, const bool samp) {
    LAS bf16* WT = (LAS bf16*)(lds);
    LAS float* xrS = (LAS float*)(lds + 18432);
    LAS float* xcS = (LAS float*)(lds + 35584);
    LAS bf16* xcB = (LAS bf16*)(lds + 51968);
    LAS float* aS = (LAS float*)(lds + 61184);
    LAS float* bS = (LAS float*)(lds + 77568);
    LAS float* sgA = (LAS float*)(lds + 93952);
    LAS float* sgB = (LAS float*)(lds + 96000);
    LAS float* hS = (LAS float*)(lds + 98048);
    LAS bf16* ygS = (LAS bf16*)(lds + 98304);
    LAS bf16* outS = (LAS bf16*)(lds + 106496);
    const int lane = tid & 63, w = tid >> 6;
    const int Tn = samp ? DT_ : T_; const int R0 = samp ? MP_ + b * DT_ : b * T_; const int ch0 = n * 64;
    for (int e = tid; e < 8192; e += 512) { const int c = e >> 7, j = e & 127;
        const float v = (j < 64) ? P.wga[(size_t)(ch0 + c) * 64 + j] : P.wgx[(size_t)(ch0 + c) * 64 + (j - 64)];
        WT[j * 72 + c] = (bf16)cvt1bf(v); }
    if (tid < 64) hS[tid] = samp ? P.state_h[b * 512 + ch0 + tid] : 0.f;
    const float cw0 = P.conv_w[0 * 512 + ch0 + lane], cw1 = P.conv_w[1 * 512 + ch0 + lane], cw2 = P.conv_w[2 * 512 + ch0 + lane], cw3 = P.conv_w[3 * 512 + ch0 + lane], cbb = P.conv_b[ch0 + lane];
    const int jt = w & 3, th = w >> 2, cm = 16 * jt + (lane & 15);
    const float ba = P.bga[ch0 + cm], bx = P.bgx[ch0 + cm];
    const float sp8 = 8.0f * LOG2E_ * log1pf(__expf(-P.lam[ch0 + cm]));
    __syncthreads();
    bf16x8 Ba[2], Bx[2];
#pragma unroll
    for (int ks = 0; ks < 2; ++ks) {
        Ba[ks] = *(const LAS bf16x8*)(WT + (16 * jt + (lane & 15)) * 72 + 32 * ks + 8 * (lane >> 4));
        Bx[ks] = *(const LAS bf16x8*)(WT + (64 + 16 * jt + (lane & 15)) * 72 + 32 * ks + 8 * (lane >> 4));
    }
    const int vr = tid >> 3, c8 = (tid & 7) * 8;
    const bf16* xrp = P.XR + (size_t)R0 * 512 + ch0 + c8; const bf16* ygp = P.YG + (size_t)R0 * 512 + ch0 + c8; bf16* lop = P.LRUO + (size_t)R0 * 512 + ch0 + c8;
    v4u xq, xq2, yq;
#define LRU_LOADX(T0) do { const int tau = (T0) + vr - 3; const v4u z_ = {0u, 0u, 0u, 0u}; \
        xq = (tau >= 0 && tau < Tn) ? *(const v4u*)(xrp + (size_t)tau * 512) : z_; \
        xq2 = (tid < 24 && tau + 64 < Tn) ? *(const v4u*)(xrp + (size_t)(tau + 64) * 512) : z_; \
        yq = ((T0) + vr < Tn) ? *(const v4u*)(ygp + (size_t)((T0) + vr) * 512) : z_; } while (0)
    LRU_LOADX(0);
    for (int t0 = 0; t0 < Tn; t0 += 64) {
        const int nvalid = (Tn - t0) < 64 ? (Tn - t0) : 64;
        { f32x4 lo_, hi_; lo_[0] = bf2f(xq[0] & 0xffffu); lo_[1] = bf2f(xq[0] >> 16); lo_[2] = bf2f(xq[1] & 0xffffu); lo_[3] = bf2f(xq[1] >> 16);
          hi_[0] = bf2f(xq[2] & 0xffffu); hi_[1] = bf2f(xq[2] >> 16); hi_[2] = bf2f(xq[3] & 0xffffu); hi_[3] = bf2f(xq[3] >> 16);
          *(LAS f32x4*)(xrS + vr * 64 + c8) = lo_; *(LAS f32x4*)(xrS + vr * 64 + c8 + 4) = hi_;
          if (tid < 24) { lo_[0] = bf2f(xq2[0] & 0xffffu); lo_[1] = bf2f(xq2[0] >> 16); lo_[2] = bf2f(xq2[1] & 0xffffu); lo_[3] = bf2f(xq2[1] >> 16);
              hi_[0] = bf2f(xq2[2] & 0xffffu); hi_[1] = bf2f(xq2[2] >> 16); hi_[2] = bf2f(xq2[3] & 0xffffu); hi_[3] = bf2f(xq2[3] >> 16);
              *(LAS f32x4*)(xrS + (64 + vr) * 64 + c8) = lo_; *(LAS f32x4*)(xrS + (64 + vr) * 64 + c8 + 4) = hi_; }
          *(LAS v4u*)(ygS + vr * 64 + c8) = yq; }
        if (samp && t0 == 0) { __syncthreads(); if (tid < 192) xrS[tid] = P.state_conv[(size_t)(b * 3 + w) * 512 + ch0 + lane]; }
        __syncthreads();
        if (t0 + 64 < Tn) LRU_LOADX(t0 + 64);
#pragma unroll
        for (int i = 0; i < 8; ++i) { const int t = w + 8 * i;
            const float v = cbb + cw0 * xrS[t * 64 + lane] + cw1 * xrS[(t + 1) * 64 + lane] + cw2 * xrS[(t + 2) * 64 + lane] + cw3 * xrS[(t + 3) * 64 + lane];
            xcS[t * 64 + lane] = v; xcB[t * 72 + lane] = (bf16)cvt1bf(v); }
        __syncthreads();
#pragma unroll
        for (int q = 0; q < 2; ++q) { const int tt = 2 * th + q; f32x4 da = {0.f, 0.f, 0.f, 0.f}, dx = {0.f, 0.f, 0.f, 0.f};
#pragma unroll
            for (int ks = 0; ks < 2; ++ks) { const bf16x8 A = *(const LAS bf16x8*)(xcB + (16 * tt + (lane & 15)) * 72 + 32 * ks + 8 * (lane >> 4));
                da = __builtin_amdgcn_mfma_f32_16x16x32_bf16(A, Ba[ks], da, 0, 0, 0); dx = __builtin_amdgcn_mfma_f32_16x16x32_bf16(A, Bx[ks], dx, 0, 0, 0); }
#pragma unroll
            for (int r = 0; r < 4; ++r) { const int t = 16 * tt + 4 * (lane >> 4) + r;
                const float rg = sigm(da[r] + ba), ig = sigm(dx[r] + bx); const float xc = xcS[t * 64 + cm];
                const float a = __builtin_amdgcn_exp2f(-sp8 * rg); const float bb = __builtin_amdgcn_sqrtf(fmaxf(1.0f - a * a, 0.f)) * ig * xc;
                aS[t * 64 + cm] = a; bS[t * 64 + cm] = bb; } }
        __syncthreads();
        float av[8], bv[8]; float Ac = 1.f, Bc = 0.f;
#pragma unroll
        for (int k = 0; k < 8; ++k) { av[k] = aS[(8 * w + k) * 64 + lane]; bv[k] = bS[(8 * w + k) * 64 + lane]; Bc = av[k] * Bc + bv[k]; Ac *= av[k]; }
        sgA[w * 64 + lane] = Ac; sgB[w * 64 + lane] = Bc;
        __syncthreads();
        float h = hS[lane];
        for (int s = 0; s < w; ++s) h = sgA[s * 64 + lane] * h + sgB[s * 64 + lane];
        float hfin = 0.f; const bool owner = ((nvalid - 1) >> 3) == w;
#pragma unroll
        for (int k = 0; k < 8; ++k) { const int t = 8 * w + k; h = av[k] * h + bv[k];
            const float g = bf2f((unsigned)ygS[t * 64 + lane]); outS[t * 64 + lane] = (bf16)cvt1bf(g * h);
            if (k == ((nvalid - 1) & 7)) hfin = h; }
        __syncthreads();
        if (owner) hS[lane] = hfin;
        if (vr < nvalid) *(v4u*)(lop + (size_t)(t0 + vr) * 512) = *(const LAS v4u*)(outS + vr * 64 + c8);
        if (t0 + 64 >= Tn) {
            float* ho = samp ? P.h_s : P.h_p; float* co = samp ? P.conv_s : P.conv_p;
            if (owner) ho[b * 512 + ch0 + lane] = hfin;
            if (tid < 192) co[(size_t)(b * 3 + w) * 512 + ch0 + lane] = xrS[(nvalid + w) * 64 + lane];
        }
    }
    __syncthreads();
#undef LRU_LOADX
}

__device__ __forceinline__ void cumsum_unit(LAS unsigned char* lds, const int tid, const float* lf  , float* cbo) {
    LAS float* wt = (LAS float*)lds;
    const int lane = tid & 63, w = tid >> 6;
    float v[4];
#pragma unroll
    for (int i = 0; i < 4; ++i) v[i] = lf[(size_t)(4 * tid + i) * 8];
    const float s = (v[0] + v[1]) + (v[2] + v[3]); float inc = s;
#pragma unroll
    for (int o = 1; o < 64; o <<= 1) { const float y = __shfl_up(inc, o); if (lane >= o) inc += y; }
    if (lane == 63) wt[w] = inc;
    __syncthreads();
    float off = 0.f; for (int i = 0; i < w; ++i) off += wt[i];
    float c = off + inc - s; f32x4 o;
#pragma unroll
    for (int i = 0; i < 4; ++i) { c += v[i]; o[i] = -c * LOG2E_; }
    *(f32x4*)(cbo + 4 * tid) = o;
    __syncthreads();
}

struct SampP { const bf16* Q; bf16* O; const float *ck, *cv, *clf, *ks, *vs, *lfs; };
__device__ __forceinline__ void sattn_unit(LAS unsigned char* lds, const int tid, const SampP& P, const int b, const int h) {
    constexpr int NK = PAST_ + DT_, SP = 1064;
    LAS float* cbs = (LAS float*)(lds);
    LAS float* S = (LAS float*)(lds + 4352);
    LAS float* red = (LAS float*)(lds + 72448);
    LAS float* wt = (LAS float*)(lds + 105216);
    const int lane = tid & 63, w = tid >> 6, l15 = lane & 15, l4 = lane >> 4;
    {
        float v[3];
#pragma unroll
        for (int i = 0; i < 3; ++i) { const int j = 3 * tid + i; v[i] = 0.f;
            if (j < PAST_) v[i] = P.clf[((size_t)b * PAST_ + j) * 8 + h]; else if (j < NK) v[i] = P.lfs[((size_t)b * DT_ + (j - PAST_)) * 8 + h]; }
        const float s = v[0] + v[1] + v[2]; float inc = s;
#pragma unroll
        for (int o = 1; o < 64; o <<= 1) { const float y = __shfl_up(inc, o); if (lane >= o) inc += y; }
        if (lane == 63) wt[w] = inc;
        __syncthreads();
        float off = 0.f; for (int i = 0; i < w; ++i) off += wt[i];
        float c = off + inc - s;
#pragma unroll
        for (int i = 0; i < 3; ++i) { const int j = 3 * tid + i; c += v[i]; if (j < NK) cbs[j] = -c * LOG2E_; }
    }
    __syncthreads();
    {
        const bf16* qrow = P.Q + (size_t)(MP_ + b * DT_ + l15) * 512 + h * 64;
        bf16x8 Qf[2];
#pragma unroll
        for (int ks = 0; ks < 2; ++ks) Qf[ks] = *(const bf16x8*)(qrow + 32 * ks + 8 * l4);
        for (int g = w; g < NK / 16; g += 8) {
            const int key = 16 * g + l15;
            const float* kp = key < PAST_ ? P.ck + (((size_t)b * PAST_ + key) * 8 + h) * 64 : P.ks + ((size_t)(b * DT_ + key - PAST_) * 512 + h * 64);
            f32x4 d = {0.f, 0.f, 0.f, 0.f};
#pragma unroll
            for (int ks = 0; ks < 2; ++ks) { const f32x4 k0 = *(const f32x4*)(kp + 32 * ks + 8 * l4), k1 = *(const f32x4*)(kp + 32 * ks + 8 * l4 + 4);
                v4u pk; pk.x = pk2(k0[0], k0[1]); pk.y = pk2(k0[2], k0[3]); pk.z = pk2(k1[0], k1[1]); pk.w = pk2(k1[2], k1[3]);
                d = __builtin_amdgcn_mfma_f32_16x16x32_bf16(Qf[ks], __builtin_bit_cast(bf16x8, pk), d, 0, 0, 0); }
            const float cbk = cbs[key];
#pragma unroll
            for (int r = 0; r < 4; ++r) { const int q = 4 * l4 + r; float s = d[r] + cbk; if (key - PAST_ > q) s = -INFINITY; S[q * SP + key] = s; }
        }
    }
    __syncthreads();
#pragma unroll
    for (int qq = 0; qq < 2; ++qq) { const int q = 2 * w + qq; float m = -INFINITY;
        for (int j = lane; j < NK; j += 64) m = fmaxf(m, S[q * SP + j]);
        m = wave_max(m); float sum = 0.f;
        for (int j = lane; j < NK; j += 64) { const float p = __builtin_amdgcn_exp2f(S[q * SP + j] - m); S[q * SP + j] = p; sum += p; }
        if (lane < 16) S[q * SP + NK + lane] = 0.f;
        sum = wave_sum(sum); if (lane == 0) wt[16 + q] = sum; }
    __syncthreads();
    {
        f32x4 acc[4];
#pragma unroll
        for (int dt = 0; dt < 4; ++dt) acc[dt] = (f32x4){0.f, 0.f, 0.f, 0.f};
        for (int ch = w; ch < 33; ch += 8) {
            const int key0 = 32 * ch + 8 * l4;
            const f32x4 p0 = *(const LAS f32x4*)(S + l15 * SP + key0), p1 = *(const LAS f32x4*)(S + l15 * SP + key0 + 4);
            v4u pp; pp.x = pk2(p0[0], p0[1]); pp.y = pk2(p0[2], p0[3]); pp.z = pk2(p1[0], p1[1]); pp.w = pk2(p1[2], p1[3]);
            const bf16x8 Pf = __builtin_bit_cast(bf16x8, pp);
            float vv[4][8];
#pragma unroll
            for (int jj = 0; jj < 8; ++jj) { int key = key0 + jj; key = key < NK ? key : NK - 1;
                const float* vp = key < PAST_ ? P.cv + (((size_t)b * PAST_ + key) * 8 + h) * 64 : P.vs + ((size_t)(b * DT_ + key - PAST_) * 512 + h * 64);
#pragma unroll
                for (int dt = 0; dt < 4; ++dt) vv[dt][jj] = vp[16 * dt + l15]; }
#pragma unroll
            for (int dt = 0; dt < 4; ++dt) { v4u pv_; pv_.x = pk2(vv[dt][0], vv[dt][1]); pv_.y = pk2(vv[dt][2], vv[dt][3]); pv_.z = pk2(vv[dt][4], vv[dt][5]); pv_.w = pk2(vv[dt][6], vv[dt][7]);
                acc[dt] = __builtin_amdgcn_mfma_f32_16x16x32_bf16(Pf, __builtin_bit_cast(bf16x8, pv_), acc[dt], 0, 0, 0); }
        }
#pragma unroll
        for (int dt = 0; dt < 4; ++dt)
#pragma unroll
            for (int r = 0; r < 4; ++r) red[(w * 16 + 4 * l4 + r) * 64 + 16 * dt + l15] = acc[dt][r];
    }
    __syncthreads();
#pragma unroll
    for (int i = 0; i < 2; ++i) { const int e = tid + 512 * i, q = e >> 6, d = e & 63; float s = 0.f;
#pragma unroll
        for (int ww = 0; ww < 8; ++ww) s += red[(ww * 16 + q) * 64 + d];
        s *= __builtin_amdgcn_rcpf(wt[16 + q]);
        P.O[(size_t)(MP_ + b * DT_ + q) * 512 + h * 64 + d] = (bf16)f2bf(s); }
    __syncthreads();
}

typedef const __attribute__((address_space(4))) Args* ArgsK;
#define PH_BEGIN() ArgsK A = ap; asm volatile("" : "+s"(A)); int tid = threadIdx.x; asm volatile("" : "+v"(tid)); \
    const int lane = tid & 63, wave = __builtin_amdgcn_readfirstlane(tid >> 6); (void)lane; (void)wave; \
    unsigned char* ws = A->ws; float* out = A->out; (void)out; \
    float* ssb = (float*)(ws + WS_SS); float* cbp = (float*)(ws + WS_CB); bf16* XB = (bf16*)(ws + WS_XB); (void)ssb; (void)cbp; (void)XB; \
    bf16* QO = (bf16*)(ws + WS_ACT); bf16* KB = (bf16*)(ws + WS_ACT + SLOT); bf16* VB = (bf16*)(ws + WS_ACT + 2 * SLOT); bf16* XRB = (bf16*)(ws + WS_ACT + 3 * SLOT); \
    bf16* YGB = (bf16*)(ws + WS_ACT + 4 * SLOT); bf16* LRUO = (bf16*)(ws + WS_ACT + 5 * SLOT); bf16* MIX = (bf16*)(ws + WS_ACT + 6 * SLOT); bf16* HB = (bf16*)(ws + WS_ACT); \
    (void)QO; (void)KB; (void)VB; (void)XRB; (void)YGB; (void)LRUO; (void)MIX; (void)HB; \
    const int gw = bid * 8 + wave, NGW = G * 8; (void)gw; (void)NGW;
#define LAYER_PTRS() bf16* wl = (bf16*)(ws + WS_W + (size_t)l * WS_WL); \
const bf16* win_t = wl; const bf16* wout_t = (const bf16*)((unsigned char*)wl + 6 * MiB); const bf16* wup_t = (const bf16*)((unsigned char*)wl + 8 * MiB); const bf16* wdn_t = (const bf16*)((unsigned char*)wl + 16 * MiB); \
float* kp = out + O_KP + (size_t)l * MP_ * 512; float* vp = out + O_VP + (size_t)l * MP_ * 512; float* lfp = out + O_LFP + (size_t)l * MP_ * 8; \
float* ksm = out + O_KS + (size_t)l * MS_ * 512; float* vsm = out + O_VS + (size_t)l * MS_ * 512; float* lfs = out + O_LFS + (size_t)l * MS_ * 8; \
    (void)win_t; (void)wout_t; (void)wup_t; (void)wdn_t; (void)kp; (void)vp; (void)lfp; (void)ksm; (void)vsm; (void)lfs;
__global__ void __launch_bounds__(512, 2) hymba_fwd(Args args_unused) {
    extern __shared__ __attribute__((aligned(16))) unsigned char lds_raw[];
    cg::grid_group grid = cg::this_grid();
    LAS unsigned char* lds = (LAS unsigned char*)lds_raw;
    const ArgsK ap = (ArgsK)__builtin_amdgcn_kernarg_segment_ptr();
    const int G = gridDim.x, bid = blockIdx.x;
    const int lo = ap->ph_lo, hi = ap->ph_hi;
#define IN(k) (lo <= (k) && (k) < hi)
#define SEAM(k) do { if (IN(k) && IN((k) + 1)) grid.sync(); } while (0)

    if (PK(0) && IN(0)) {
        PH_BEGIN();
        LAS float* scr = (LAS float*)(lds + wave * 16384);
        constexpr int I_IN = 16 * 88, I_OUT = 16 * 32, I_UP = 16 * 128, I_DN = 64 * 32, I_L = I_IN + I_OUT + I_UP + I_DN;
        for (int it = gw; it < 2 * I_L; it += NGW) {
            const int l = it / I_L; int r = it % I_L;
            bf16* wl = (bf16*)(ws + WS_W + (size_t)l * WS_WL);
            if (r < I_IN) { transpose_item<1>(A->in[8] + (size_t)l * 1024 * INW_, 1024, INW_, A->in[7] + l * 1024, nullptr, wl, scr, r / 88, r % 88, lane); continue; } r -= I_IN;
            if (r < I_OUT) { transpose_item<0>(A->in[21] + (size_t)l * 1024 * 1024, 1024, 1024, A->in[19] + l * 512, A->in[20] + l * 512, (bf16*)((unsigned char*)wl + 6 * MiB), scr, r / 32, r % 32, lane); continue; } r -= I_OUT;
            if (r < I_UP) { transpose_item<0>(A->in[23] + (size_t)l * 1024 * 4096, 1024, 4096, A->in[22] + l * 1024, nullptr, (bf16*)((unsigned char*)wl + 8 * MiB), scr, r / 128, r % 128, lane); continue; } r -= I_UP;
            transpose_item<0>(A->in[24] + (size_t)l * 4096 * 1024, 4096, 1024, nullptr, nullptr, (bf16*)((unsigned char*)wl + 16 * MiB), scr, r / 32, r % 32, lane);
        }
        for (int m0 = gw * 4; m0 < M_; m0 += NGW * 4) {
            f32x4 v[4][4];
#pragma unroll
            for (int r = 0; r < 4; ++r) { const int m = m0 + r; const float* xr = m < MP_ ? A->in[0] + (size_t)m * 1024 : A->in[1] + (size_t)(m - MP_) * 1024;
#pragma unroll
                for (int j = 0; j < 4; ++j) v[r][j] = *(const f32x4*)(xr + 256 * j + 4 * lane); }
#pragma unroll
            for (int r = 0; r < 4; ++r) { const int m = m0 + r; float s = 0.f;
#pragma unroll
                for (int j = 0; j < 4; ++j) s += (v[r][j][0] * v[r][j][0] + v[r][j][1] * v[r][j][1]) + (v[r][j][2] * v[r][j][2] + v[r][j][3] * v[r][j][3]);
                s = wave_sum(s);
#pragma unroll
                for (int j = 0; j < 4; ++j) { v2u o; o.x = pk2(v[r][j][0], v[r][j][1]); o.y = pk2(v[r][j][2], v[r][j][3]); *(v2u*)(XB + (size_t)m * 1024 + 256 * j + 4 * lane) = o; }
                if (lane == 0) { ssb[m] = s; ssb[M_ + m] = 0.f; ssb[2 * M_ + m] = 0.f; ssb[3 * M_ + m] = 0.f; } }
        }
    }
    SEAM(0);
#ifdef PROBE_SYNC
    for (int i_ = 0; i_ < 8; ++i_) grid.sync();
#endif

#pragma unroll 1
    for (int l = 0; l < DEPTH_; ++l) {
        const int pb = 1 + 7 * l;
        if (PK(1) && IN(pb)) {
            PH_BEGIN(); LAYER_PTRS();
            pg8::Gemm g{XB, win_t, M_, NIN_, 1024}; pg8::StaticOrder S; S.init(M_, NIN_, G, bid);
            pg8::EpiIn E{QO, out, SLOT / 2, l, ssb + (size_t)l * M_, A->in[10] + l * 64, A->in[11] + l * 64, A->in[9] + l * 8};
            pg8::gemm_phase<pg8::EpiIn, pg8::StaticOrder, true, true, true>(lds, g, S, E);
        }
        SEAM(pb);

        if (PK(2) && IN(pb + 1)) {
            PH_BEGIN(); LAYER_PTRS();
            LayerP P;
            P.conv_w = A->in[12] + l * 2048; P.conv_b = A->in[13] + l * 512; P.wga = A->in[14] + (size_t)l * 32768; P.bga = A->in[15] + l * 512;
            P.wgx = A->in[16] + (size_t)l * 32768; P.bgx = A->in[17] + l * 512; P.lam = A->in[18] + l * 512;
            P.state_h = A->in[5] + (size_t)l * DB_ * 512; P.state_conv = A->in[6] + (size_t)l * DB_ * 3 * 512;
            P.XR = XRB; P.YG = YGB; P.LRUO = LRUO;
            P.h_p = out + O_HP + (size_t)l * NB_ * 512; P.conv_p = out + O_CP + (size_t)l * NB_ * 3 * 512; P.h_s = out + O_HS + (size_t)l * DB_ * 512; P.conv_s = out + O_CS + (size_t)l * DB_ * 3 * 512;
            for (int u = bid; u < 256; u += G) lru_unit(lds, tid, P, u >> 3, u & 7, false);
#ifdef PROBE_LRU
            for (int u = bid; u < 256; u += G) lru_unit(lds, tid, P, u >> 3, u & 7, false);
#endif
            for (int u = bid; u < 256; u += G) lru_unit(lds, tid, P, u >> 3, u & 7, true);
            for (int u = bid; u < 256; u += G) cumsum_unit(lds, tid, lfp + (size_t)(u >> 3) * T_ * 8 + (u & 7), cbp + (size_t)u * T_);
        }
        SEAM(pb + 1);

        if (PK(3) && IN(pb + 2)) {
            PH_BEGIN(); LAYER_PTRS();
#ifdef PROBE_ATTN
            for (int u = bid; u < 256; u += G) {
#pragma unroll 1
                for (int qb = 7; qb >= 0; --qb)
                    attn_body::attn_unit<64>(u >> 3, u & 7, qb, (const attn_body::bf16*)QO, (const attn_body::bf16*)KB, (const attn_body::bf16*)VB, (attn_body::bf16*)MIX, cbp + (size_t)u * T_, (char*)lds_raw);
            }
#endif
            if (PK(8)) for (int u = bid; u < 256; u += G) {
#pragma unroll 1
                for (int qb = 7; qb >= 0; --qb)
                    attn_body::attn_unit<64>(u >> 3, u & 7, qb, (const attn_body::bf16*)QO, (const attn_body::bf16*)KB, (const attn_body::bf16*)VB, (attn_body::bf16*)QO, cbp + (size_t)u * T_, (char*)lds_raw);
            }
            SampP SPp{QO, QO, A->in[2] + (size_t)l * DB_ * PAST_ * 512, A->in[3] + (size_t)l * DB_ * PAST_ * 512, A->in[4] + (size_t)l * DB_ * PAST_ * 8, ksm, vsm, lfs};
            if (PK(9)) for (int u = bid; u < 256; u += G) sattn_unit(lds, tid, SPp, u >> 3, u & 7);
        }
        SEAM(pb + 2);

        if (PK(4) && IN(pb + 3)) {
            PH_BEGIN(); LAYER_PTRS();
            for (int m0 = gw * 4; m0 < M_; m0 += NGW * 4) {
                v4u a[4], c[4];
#pragma unroll
                for (int r = 0; r < 4; ++r) { a[r] = *(const v4u*)(QO + (size_t)(m0 + r) * 512 + 8 * lane); c[r] = *(const v4u*)(LRUO + (size_t)(m0 + r) * 512 + 8 * lane); }
#pragma unroll
                for (int r = 0; r < 4; ++r) { const int m = m0 + r;
                    float fa[8], fc[8]; float sa = 0.f, sc = 0.f;
#pragma unroll
                    for (int j = 0; j < 4; ++j) { fa[2 * j] = bf2f(a[r][j] & 0xffffu); fa[2 * j + 1] = bf2f(a[r][j] >> 16); fc[2 * j] = bf2f(c[r][j] & 0xffffu); fc[2 * j + 1] = bf2f(c[r][j] >> 16); }
#pragma unroll
                    for (int j = 0; j < 8; ++j) { sa += fa[j] * fa[j]; sc += fc[j] * fc[j]; }
                    sa = wave_sum(sa); sc = wave_sum(sc);
                    const float ra = 1.0f / sqrtf(sa * (1.0f / 512.0f) + EPS_), rc = 1.0f / sqrtf(sc * (1.0f / 512.0f) + EPS_);
                    v4u oa, oc;
#pragma unroll
                    for (int j = 0; j < 4; ++j) { oa[j] = pk2(fa[2 * j] * ra, fa[2 * j + 1] * ra); oc[j] = pk2(fc[2 * j] * rc, fc[2 * j + 1] * rc); }
                    *(v4u*)(MIX + (size_t)m * 1024 + 8 * lane) = oa; *(v4u*)(MIX + (size_t)m * 1024 + 512 + 8 * lane) = oc; }
            }
        }
        SEAM(pb + 3);

        if (PK(5) && IN(pb + 4)) {
            PH_BEGIN(); LAYER_PTRS();
            pg8::Gemm g{MIX, wout_t, M_, 1024, 1024}; pg8::StaticOrder S; S.init(M_, 1024, G, bid);
            pg8::EpiRes E{l == 0 ? A->in[0] : out, l == 0 ? A->in[1] : out + (size_t)MP_ * 1024, out, XB, ssb + (size_t)(2 + l) * M_, 1};
            pg8::gemm_phase<pg8::EpiRes, pg8::StaticOrder, true, true, false>(lds, g, S, E);
        }
        SEAM(pb + 4);

        if (PK(6) && IN(pb + 5)) {
            PH_BEGIN(); LAYER_PTRS();
            pg8::Gemm g{XB, wup_t, M_, FF_, 1024}; pg8::StaticOrder S; S.init(M_, FF_, G, bid);
            pg8::EpiUp E{HB, ssb + (size_t)(2 + l) * M_};
            pg8::gemm_phase<pg8::EpiUp, pg8::StaticOrder, true, true, false>(lds, g, S, E);
#ifdef PROBE_UP2
            pg8::gemm_phase<pg8::EpiUp, pg8::StaticOrder, true, true, false>(lds, g, S, E);
#endif
        }
        SEAM(pb + 5);

        if (PK(7) && IN(pb + 6)) {
            PH_BEGIN(); LAYER_PTRS();
            pg8::Gemm g{HB, wdn_t, M_, 1024, FF_}; pg8::StaticOrder S; S.init(M_, 1024, G, bid);
            pg8::EpiRes E{out, out + (size_t)MP_ * 1024, out, XB, ssb + (size_t)M_, l == 0 ? 1 : 0};
            pg8::gemm_phase<pg8::EpiRes, pg8::StaticOrder, true, true, false>(lds, g, S, E);
        }
        SEAM(pb + 6);
    }
#undef IN
#undef SEAM
}

extern "C" void kernel_launch(void* const* d_in, const int* in_sizes, int n_in, void* d_out, int out_size, void* d_ws, size_t ws_size, hipStream_t stream) {
    static int grid = 0;
    if (grid == 0) {
        if (n_in != 25 || (size_t)out_size != O_END || ws_size < WS_END) { fprintf(stderr, "kernel_launch: unexpected problem (n_in %d out %d ws %zu need %zu)\n", n_in, out_size, ws_size, (size_t)WS_END); grid = -1; return; }
        int dev = 0, cus = 0, per_cu = 0;
        hipGetDevice(&dev); hipDeviceGetAttribute(&cus, hipDeviceAttributeMultiprocessorCount, dev);
        if (hipFuncSetAttribute((const void*)hymba_fwd, hipFuncAttributeMaxDynamicSharedMemorySize, LDS_BYTES) != hipSuccess) { fprintf(stderr, "kernel_launch: hipFuncSetAttribute failed\n"); (void)hipGetLastError(); }
        if (hipOccupancyMaxActiveBlocksPerMultiprocessor(&per_cu, (const void*)hymba_fwd, 512, LDS_BYTES) != hipSuccess || per_cu < 1) { fprintf(stderr, "kernel_launch: occupancy query says %d\n", per_cu); per_cu = 1; (void)hipGetLastError(); }
        grid = cus * per_cu;
        fprintf(stderr, "kernel_launch: grid %d (cus %d x %d)\n", grid, cus, per_cu);
    }
    if (grid < 0) return;
    Args a{};
    for (int i = 0; i < 25; ++i) a.in[i] = (const float*)d_in[i];
    a.out = (float*)d_out; a.ws = (unsigned char*)d_ws; a.ph_lo = 0; a.ph_hi = NPHASE;
    void* kargs[] = {&a};
    hipError_t e = hipLaunchCooperativeKernel((const void*)hymba_fwd, dim3(grid), dim3(512), kargs, LDS_BYTES, stream);
    if (e != hipSuccess) fprintf(stderr, "kernel_launch: cooperative launch failed: %s (grid %d)\n", hipGetErrorString(e), grid);
}
```

```cpp
#include <hip/hip_runtime.h>
#include <hip/hip_cooperative_groups.h>
#include <hip/hip_bf16.h>
#include <cstdio>
#include <cstdint>
#include <cmath>
namespace cg = cooperative_groups;

constexpr int DM_ = 1024, NB_ = 32, T_ = 2048, DB_ = 32, DT_ = 16, PAST_ = 1024, NH_ = 8, HD_ = 64, AW_ = 512, LW_ = 512, FF_ = 4096, DEPTH_ = 2;
constexpr int MP_ = NB_ * T_;
constexpr int MS_ = DB_ * DT_;
constexpr int M_ = MP_ + MS_;
constexpr int NIN_ = 2816;
constexpr int INW_ = 2568;
constexpr float EPS_ = 1e-6f;
constexpr float LOG2E_ = 1.4426950408889634f;
constexpr float C2_ = 0.125f * 1.4426950408889634f;

namespace pg8 {
#define PG8_LAS __attribute__((address_space(3)))
typedef unsigned short bf16_t;
typedef short bf16x8 __attribute__((ext_vector_type(8)));
typedef float f32x4 __attribute__((ext_vector_type(4)));
typedef unsigned u32x4 __attribute__((ext_vector_type(4)));
constexpr int BM = 256, BK = 64, HALF = 128, HTB = HALF * BK * 2  , STAGE_BYTES = 8 * HTB, NXCD = 8, WGM = 8;

__host__ __device__ __forceinline__ int lds_byte(int r, int c) { const int st = (r >> 4) * 2 + (c >> 5), rr = r & 15, cc = c & 31, ob = rr * 64 + cc * 2; return st * 1024 + (ob ^ (((ob >> 9) & 1) << 5)); }
__host__ __device__ __forceinline__ void stage_rc(int b, int& R, int& C) { const int st = b / 1024, sb = b % 1024, swz = sb ^ (((sb >> 9) & 1) << 5); R = (st >> 1) * 16 + swz / 64; C = (st & 1) * 32 + (swz % 64) / 2; }
__host__ __device__ __forceinline__ int perm32(int rho) { const int n = rho >> 4, i = rho & 15; return 8 * (i >> 2) + 4 * n + (i & 3); }

struct Unit { int pm, pn, kb; };
struct Gemm { const bf16_t* A; const bf16_t* Bt; int M, N, K, ldk; };

struct StaticOrder {
    int nM, nN, nwg, G, c;
    __host__ __device__ void init(int M, int N, int G_, int c_) { nM = M / BM; nN = N / BM; nwg = nM * nN; G = G_; c = c_; }
    __host__ __device__ bool next(int i, Unit& u) const {
        const long L = (long)i * G + c; if (L >= nwg) return false;
        int wgid = (int)L; { const int q = nwg / NXCD, r = nwg % NXCD, xcd = wgid % NXCD, off = wgid / NXCD; wgid = (xcd < r ? xcd * (q + 1) : r * (q + 1) + (xcd - r) * q) + off; }
        const int nig = WGM * nN, gid = wgid / nig, fm = gid * WGM, gsz = (nM - fm) < WGM ? (nM - fm) : WGM;
        u.pm = fm + ((wgid % nig) % gsz); u.pn = (wgid % nig) / gsz; u.kb = 0; return true;
    }
    __device__ __forceinline__ void a_ready(const Unit&) const {}
    __device__ __forceinline__ void done(const Unit&) const {}
};

__device__ __forceinline__ unsigned cvt_pk_bf16(float lo, float hi) { unsigned r; asm volatile("v_cvt_pk_bf16_f32 %0, %1, %2" : "=v"(r) : "v"(lo), "v"(hi)); return r; }

typedef float f32x2 __attribute__((ext_vector_type(2)));
__device__ __forceinline__ float gelu_tanh(float x) {
    const float u = 0.7978845608028654f * (x + 0.044715f * x * x * x);
    const float e = __builtin_amdgcn_exp2f(-2.0f * 1.4426950408889634f * u);
    return x * __builtin_amdgcn_rcpf(1.0f + e);
}
__device__ __forceinline__ float log_sigmoid_f(float z) { return fminf(z, 0.f) - log1pf(__expf(-fabsf(z))); }

struct EpiIn {
    static constexpr bool PERM = true, AFTER_DRAIN = false;
    bf16_t* act; float* out; size_t slot; int l; const float *ss, *qg, *kg, *bfp;
    __device__ __forceinline__ void operator()(const f32x4 (&acc)[2][2][4][2], const Unit& u, int wr, int wc, int fr, int fq) const {
        const int kind = u.pn >> 1;
        const bool samp = u.pm >= (65536 / 256);
        const int colb = (u.pn & 1) * 256 + 64 * wc + 8 * fq;
        f32x4 g[2][2];
#pragma unroll
        for (int bj = 0; bj < 2; ++bj)
#pragma unroll
            for (int n = 0; n < 2; ++n) {
                g[bj][n] = (f32x4){1.f, 1.f, 1.f, 1.f};
                if (kind == 0) g[bj][n] = *(const f32x4*)(qg + 32 * bj + 8 * fq + 4 * n) * (0.125f * 1.4426950408889634f);
                if (kind == 1) g[bj][n] = *(const f32x4*)(kg + 32 * bj + 8 * fq + 4 * n);
            }
        float rsv[2][4];
#pragma unroll
        for (int ai = 0; ai < 2; ++ai)
#pragma unroll
            for (int m = 0; m < 4; ++m) rsv[ai][m] = ss[u.pm * BM + ai * HALF + wr * 64 + m * 16 + fr];
#pragma unroll
        for (int ai = 0; ai < 2; ++ai)
#pragma unroll
            for (int m = 0; m < 4; ++m) {
                const int row = u.pm * BM + ai * HALF + wr * 64 + m * 16 + fr;
                const float rs = __builtin_amdgcn_rsqf(rsv[ai][m] * (1.0f / 1024.0f) + 1e-6f);
                f32x4 v[2][2];
#pragma unroll
                for (int bj = 0; bj < 2; ++bj)
#pragma unroll
                    for (int n = 0; n < 2; ++n) v[bj][n] = acc[ai][bj][m][n] * rs;
                if (kind <= 1) {
                    float s = 0.f;
#pragma unroll
                    for (int bj = 0; bj < 2; ++bj)
#pragma unroll
                        for (int n = 0; n < 2; ++n) { const f32x4 x = v[bj][n]; s += (x[0] * x[0] + x[1] * x[1]) + (x[2] * x[2] + x[3] * x[3]); }
                    s += __shfl_xor(s, 16); s += __shfl_xor(s, 32);
                    const float inv = __builtin_amdgcn_rsqf(s * (1.0f / 64.0f) + 1e-6f);
#pragma unroll
                    for (int bj = 0; bj < 2; ++bj)
#pragma unroll
                        for (int n = 0; n < 2; ++n) v[bj][n] = v[bj][n] * inv * g[bj][n];
                }
                if (kind == 5) {
                    if (wc == 0 && fq == 0) {
                        float* lf = out + (samp ? (size_t)204079104 + (size_t)l * 4096 + (size_t)(row - 65536) * 8 : (size_t)201850880 + (size_t)l * 524288 + (size_t)row * 8);
#pragma unroll
                        for (int n = 0; n < 2; ++n) { const f32x4 b = *(const f32x4*)(bfp + 4 * n); f32x4 o;
#pragma unroll
                            for (int j = 0; j < 4; ++j) o[j] = log_sigmoid_f(v[0][n][j] + b[j]);
                            *(f32x4*)(lf + 4 * n) = o; }
                    }
                } else {
                    if (kind == 4) {
#pragma unroll
                        for (int bj = 0; bj < 2; ++bj)
#pragma unroll
                            for (int n = 0; n < 2; ++n)
#pragma unroll
                                for (int j = 0; j < 4; ++j) v[bj][n][j] = gelu_tanh(v[bj][n][j]);
                    }
                    bf16_t* rowp = act + (size_t)kind * slot + (size_t)row * 512 + colb;
#pragma unroll
                    for (int bj = 0; bj < 2; ++bj) { u32x4 w; w.x = cvt_pk_bf16(v[bj][0][0], v[bj][0][1]); w.y = cvt_pk_bf16(v[bj][0][2], v[bj][0][3]); w.z = cvt_pk_bf16(v[bj][1][0], v[bj][1][1]); w.w = cvt_pk_bf16(v[bj][1][2], v[bj][1][3]);
                        *(u32x4*)(rowp + 32 * bj) = w; }
                    if ((kind == 1 || kind == 2) && samp) {
                        const size_t ob = samp ? (size_t)203030528 + (size_t)(kind - 1) * 524288 + (size_t)l * 262144 + (size_t)(row - 65536) * 512
                                               : (size_t)67633152 + (size_t)(kind - 1) * 67108864 + (size_t)l * 33554432 + (size_t)row * 512;
                        float* op = out + ob + colb;
#pragma unroll
                        for (int bj = 0; bj < 2; ++bj)
#pragma unroll
                            for (int n = 0; n < 2; ++n) *(f32x4*)(op + 32 * bj + 4 * n) = v[bj][n];
                    }
                }
            }
    }
};

struct EpiRes {
    static constexpr bool PERM = true, AFTER_DRAIN = false;
    const float* xin_p; const float* xin_s; float* yout; bf16_t* xb; float* ssacc; int wb;
    __device__ __forceinline__ void operator()(const f32x4 (&acc)[2][2][4][2], const Unit& u, int wr, int wc, int fr, int fq) const {
        const bool samp = u.pm >= (65536 / 256);
        const int col0 = u.pn * BM + wc * 32 + 8 * fq;
        const float* xbase = samp ? xin_s + (size_t)(u.pm * BM - 65536) * 1024 : xin_p + (size_t)(u.pm * BM) * 1024;
#pragma unroll
        for (int ai = 0; ai < 2; ++ai) {
            f32x4 pre[4][2][2];
#pragma unroll
            for (int m = 0; m < 4; ++m) { const float* xr_ = xbase + (size_t)(ai * HALF + wr * 64 + m * 16 + fr) * 1024 + col0;
#pragma unroll
                for (int bj = 0; bj < 2; ++bj) { pre[m][bj][0] = *(const f32x4*)(xr_ + bj * HALF); pre[m][bj][1] = *(const f32x4*)(xr_ + bj * HALF + 4); } }
#pragma unroll
            for (int m = 0; m < 4; ++m) {
                const int row = u.pm * BM + ai * HALF + wr * 64 + m * 16 + fr;
                float* yr = yout + (size_t)row * 1024;
                float s = 0.f;
#pragma unroll
                for (int bj = 0; bj < 2; ++bj) {
                    const f32x4 x0 = pre[m][bj][0] + acc[ai][bj][m][0];
                    const f32x4 x1 = pre[m][bj][1] + acc[ai][bj][m][1];
                    *(f32x4*)(yr + col0 + bj * HALF) = x0; *(f32x4*)(yr + col0 + bj * HALF + 4) = x1;
                    if (wb) {
                        s += (x0[0] * x0[0] + x0[1] * x0[1]) + (x0[2] * x0[2] + x0[3] * x0[3]) + (x1[0] * x1[0] + x1[1] * x1[1]) + (x1[2] * x1[2] + x1[3] * x1[3]);
                        u32x4 w; w.x = cvt_pk_bf16(x0[0], x0[1]); w.y = cvt_pk_bf16(x0[2], x0[3]); w.z = cvt_pk_bf16(x1[0], x1[1]); w.w = cvt_pk_bf16(x1[2], x1[3]);
                        *(u32x4*)(xb + (size_t)row * 1024 + col0 + bj * HALF) = w;
                    }
                }
                if (wb) { s += __shfl_xor(s, 16); s += __shfl_xor(s, 32); if (fq == 0) atomicAdd(ssacc + row, s); }
            }
            asm volatile("" ::: "memory");
        }
    }
};

struct SampSplitOrder {
    int c;
    __host__ __device__ bool next(int i, Unit& u) const { if (i != 0 || c >= 32) return false; u.pm = 256 + (c >> 4); u.pn = (c >> 2) & 3; u.kb = (c & 3) * 1024; return true; }
    __device__ __forceinline__ void a_ready(const Unit&) const {}
    __device__ __forceinline__ void done(const Unit&) const {}
};
struct EpiAtomic {
    static constexpr bool PERM = true, AFTER_DRAIN = false;
    float* yout;
    __device__ __forceinline__ void operator()(const f32x4 (&acc)[2][2][4][2], const Unit& u, int wr, int wc, int fr, int fq) const {
        const int col0 = u.pn * BM + wc * 32 + 8 * fq;
#pragma unroll
        for (int ai = 0; ai < 2; ++ai)
#pragma unroll
            for (int m = 0; m < 4; ++m) { float* yr = yout + (size_t)(u.pm * BM + ai * HALF + wr * 64 + m * 16 + fr) * 1024 + col0;
#pragma unroll
                for (int bj = 0; bj < 2; ++bj)
#pragma unroll
                    for (int n = 0; n < 2; ++n)
#pragma unroll
                        for (int j = 0; j < 4; ++j) atomicAdd(yr + bj * HALF + 4 * n + j, acc[ai][bj][m][n][j]); }
    }
};

struct EpiUp {
    static constexpr bool PERM = true, AFTER_DRAIN = false;
    bf16_t* H; const float* ss;
    __device__ __forceinline__ void operator()(const f32x4 (&acc)[2][2][4][2], const Unit& u, int wr, int wc, int fr, int fq) const {
        const int col0 = u.pn * BM + wc * 32 + 8 * fq;
        float rsv[2][4];
#pragma unroll
        for (int ai = 0; ai < 2; ++ai)
#pragma unroll
            for (int m = 0; m < 4; ++m) rsv[ai][m] = ss[u.pm * BM + ai * HALF + wr * 64 + m * 16 + fr];
#pragma unroll
        for (int ai = 0; ai < 2; ++ai)
#pragma unroll
            for (int m = 0; m < 4; ++m) {
                const int row = u.pm * BM + ai * HALF + wr * 64 + m * 16 + fr;
                const float rs = __builtin_amdgcn_rsqf(rsv[ai][m] * (1.0f / 1024.0f) + 1e-6f);
                bf16_t* hr = H + (size_t)row * 4096 + col0;
#pragma unroll
                for (int bj = 0; bj < 2; ++bj) {
                    f32x4 x0 = acc[ai][bj][m][0] * rs, x1 = acc[ai][bj][m][1] * rs;
#pragma unroll
                    for (int j = 0; j < 4; ++j) { const float a = fmaxf(x0[j], 0.f), b = fmaxf(x1[j], 0.f); x0[j] = a * a; x1[j] = b * b; }
                    u32x4 w; w.x = cvt_pk_bf16(x0[0], x0[1]); w.y = cvt_pk_bf16(x0[2], x0[3]); w.z = cvt_pk_bf16(x1[0], x1[1]); w.w = cvt_pk_bf16(x1[2], x1[3]);
                    *(u32x4*)(hr + bj * HALF) = w;
                }
            }
    }
};

template <class Epi, class Sched, bool ALIGN_EPI = false, bool SP2 = false, bool HEADPERM = false>
__device__ __forceinline__ void gemm_phase(PG8_LAS unsigned char* lds, const Gemm g, const Sched& S, const Epi& E) {
    int tid_l = threadIdx.x; asm volatile("" : "+v"(tid_l)); const int tid = tid_l, wid = __builtin_amdgcn_readfirstlane(tid >> 6), lane = tid & 63, wr = wid >> 2, wc = wid & 3, fr = lane & 15, fq = lane >> 4;
    const int K = g.ldk, nt = g.K / BK;
    unsigned voffA[2], voffB[2];
#pragma unroll
    for (int i = 0; i < 2; ++i) { int R, C; stage_rc(tid * 16 + i * 8192, R, C); const int Rb0 = Epi::PERM ? ((R & ~31) + perm32(R & 31)) : R; const int Rb = HEADPERM ? (64 * (Rb0 >> 5) + (Rb0 & 31)) : Rb0;
        voffA[i] = (unsigned)(R * K + C) * 2u; voffB[i] = (unsigned)(Rb * K + C) * 2u; }
    const size_t kstep = (size_t)(BK * 2);
    const size_t hstep = (size_t)HALF * K * 2;
    const size_t tstep = 2 * hstep; const size_t hstepB = HEADPERM ? (size_t)32 * K * 2 : hstep;
    const unsigned ldsw = (unsigned)wid * 1024u;
    const int aoff = lds_byte(wr * 64 + fr, fq * 8), boff = lds_byte(wc * 32 + fr, fq * 8);
#define PG8_SA(b, h) (((b) * 2 + (h)) * HTB)
#define PG8_SB(b, h) ((4 + (b) * 2 + (h)) * HTB)
#define PG8_STAGE(bufoff, gbase, voff) do { _Pragma("unroll") for (int _i = 0; _i < 2; ++_i) \
        __builtin_amdgcn_global_load_lds((const unsigned*)((const char*)(gbase) + (voff)[_i]), (PG8_LAS unsigned*)(lds + (bufoff) + ldsw + _i * 8192), 16, 0, 0); } while (0)
#define PG8_LDA(dst, b, h) do { _Pragma("unroll") for (int m = 0; m < 4; ++m) _Pragma("unroll") for (int k = 0; k < 2; ++k) dst[m][k] = *(const PG8_LAS bf16x8*)(lds + PG8_SA(b, h) + aoff + m * 2048 + k * 1024); } while (0)
#define PG8_LDB(dst, b, h) do { _Pragma("unroll") for (int n = 0; n < 2; ++n) _Pragma("unroll") for (int k = 0; k < 2; ++k) dst[n][k] = *(const PG8_LAS bf16x8*)(lds + PG8_SB(b, h) + boff + n * 2048 + k * 1024); } while (0)
#define PG8_MMA(ai, bj, At, Bt) do { __builtin_amdgcn_s_setprio(1); _Pragma("unroll") for (int m = 0; m < 4; ++m) _Pragma("unroll") for (int n = 0; n < 2; ++n) _Pragma("unroll") for (int k = 0; k < 2; ++k) \
        acc[ai][bj][m][n] = __builtin_amdgcn_mfma_f32_16x16x32_bf16(Bt[n][k], At[m][k], acc[ai][bj][m][n], 0, 0, 0); __builtin_amdgcn_s_setprio(0); } while (0)
#define PG8_WAIT_V(n) asm volatile("s_waitcnt vmcnt(" #n ")" ::: "memory")
#define PG8_WAIT_L(n) asm volatile("s_waitcnt lgkmcnt(" #n ")" ::: "memory")
#define PG8_BAR __builtin_amdgcn_s_barrier()
#define PG8_SCHED __builtin_amdgcn_sched_barrier(0)
    Unit cur, nxt; int ui = 0;
    if (!S.next(0, cur)) return;
    f32x4 acc[2][2][4][2];
#pragma unroll
    for (int a = 0; a < 2; ++a)
#pragma unroll
        for (int b = 0; b < 2; ++b)
#pragma unroll
            for (int m = 0; m < 4; ++m)
#pragma unroll
                for (int n = 0; n < 2; ++n) acc[a][b][m][n] = (f32x4){0.f, 0.f, 0.f, 0.f};
    bf16x8 At[4][2], B0[2][2], B1[2][2];
    const char* cA = (const char*)g.A + (size_t)cur.pm * tstep + (size_t)cur.kb * 2; const char* cB = (const char*)g.Bt + (size_t)cur.pn * tstep + (size_t)cur.kb * 2;
    S.a_ready(cur);
    if constexpr (SP2) {
        PG8_STAGE(PG8_SB(0, 0), cB, voffB); PG8_STAGE(PG8_SB(0, 1), cB + hstepB, voffB); PG8_STAGE(PG8_SA(0, 0), cA, voffA); PG8_STAGE(PG8_SA(0, 1), cA + hstep, voffA);
        if (wr == 1) PG8_BAR;
        PG8_WAIT_V(2); PG8_BAR;
        PG8_STAGE(PG8_SB(1, 0), cB + kstep, voffB); PG8_STAGE(PG8_SA(1, 0), cA + kstep, voffA); PG8_STAGE(PG8_SB(1, 1), cB + hstepB + kstep, voffB);
        PG8_WAIT_V(6); PG8_BAR;
    } else {
        PG8_STAGE(PG8_SB(0, 0), cB, voffB); PG8_STAGE(PG8_SA(0, 0), cA, voffA); PG8_STAGE(PG8_SB(0, 1), cB + hstepB, voffB); PG8_STAGE(PG8_SA(0, 1), cA + hstep, voffA);
        if (wr == 1) PG8_BAR;
        PG8_WAIT_V(4); PG8_BAR;
        PG8_STAGE(PG8_SB(1, 0), cB + kstep, voffB); PG8_STAGE(PG8_SA(1, 0), cA + kstep, voffA); PG8_STAGE(PG8_SB(1, 1), cB + hstepB + kstep, voffB);
        PG8_WAIT_V(6); PG8_BAR;
    }
    for (;;) {
        const bool has_next = S.next(ui + 1, nxt);
        const char* nA = has_next ? (const char*)g.A + (size_t)nxt.pm * tstep + (size_t)nxt.kb * 2 : cA; const char* nB = has_next ? (const char*)g.Bt + (size_t)nxt.pn * tstep + (size_t)nxt.kb * 2 : cB;
        for (int t = 0; t < nt; t += 2) {
            const bool last = (t == nt - 2);
            const char* a1 = cA + (size_t)(t + 1) * kstep;
            const char* a2 = last ? nA : cA + (size_t)(t + 2) * kstep; const char* b2 = last ? nB : cB + (size_t)(t + 2) * kstep;
            const char* a3 = a2 + kstep; const char* b3 = b2 + kstep;
            if (last && has_next) S.a_ready(nxt);
            if constexpr (SP2) {
            PG8_LDB(B0, 0, 0); PG8_LDB(B1, 0, 1); PG8_SCHED; PG8_LDA(At, 0, 0); PG8_STAGE(PG8_SA(1, 1), a1 + hstep, voffA);
            PG8_WAIT_V(8); PG8_WAIT_L(0); PG8_BAR; PG8_MMA(0, 0, At, B0); PG8_MMA(0, 1, At, B1); PG8_BAR; PG8_SCHED;
            PG8_LDA(At, 0, 1); PG8_STAGE(PG8_SB(0, 0), b2, voffB); PG8_STAGE(PG8_SB(0, 1), b2 + hstepB, voffB); PG8_STAGE(PG8_SA(0, 0), a2, voffA);
            PG8_WAIT_V(8); PG8_WAIT_L(0); PG8_BAR; PG8_MMA(1, 0, At, B0); PG8_MMA(1, 1, At, B1); PG8_BAR; PG8_SCHED;
            PG8_LDB(B0, 1, 0); PG8_LDB(B1, 1, 1); PG8_SCHED; PG8_LDA(At, 1, 0); PG8_STAGE(PG8_SA(0, 1), a2 + hstep, voffA);
            PG8_WAIT_V(8); PG8_WAIT_L(0); PG8_BAR; PG8_MMA(0, 0, At, B0); PG8_MMA(0, 1, At, B1); PG8_BAR; PG8_SCHED;
            PG8_LDA(At, 1, 1); PG8_STAGE(PG8_SB(1, 0), b3, voffB); PG8_STAGE(PG8_SB(1, 1), b3 + hstepB, voffB); PG8_STAGE(PG8_SA(1, 0), a3, voffA);
            PG8_WAIT_V(8); PG8_WAIT_L(0); PG8_BAR; PG8_MMA(1, 0, At, B0); PG8_MMA(1, 1, At, B1); PG8_BAR; PG8_SCHED;
            } else {
            PG8_LDB(B0, 0, 0); PG8_SCHED; PG8_LDA(At, 0, 0); PG8_STAGE(PG8_SA(1, 1), a1 + hstep, voffA);
            PG8_WAIT_L(8); PG8_BAR; PG8_WAIT_L(0); PG8_MMA(0, 0, At, B0); PG8_BAR; PG8_SCHED;
            PG8_LDB(B1, 0, 1); PG8_STAGE(PG8_SB(0, 0), b2, voffB);
            PG8_BAR; PG8_WAIT_L(0); PG8_MMA(0, 1, At, B1); PG8_BAR;
            PG8_LDA(At, 0, 1); PG8_STAGE(PG8_SA(0, 0), a2, voffA);
            PG8_BAR; PG8_WAIT_L(0); PG8_MMA(1, 0, At, B0); PG8_BAR; PG8_SCHED;
            PG8_STAGE(PG8_SB(0, 1), b2 + hstepB, voffB);
            PG8_WAIT_V(6); PG8_BAR; PG8_MMA(1, 1, At, B1); PG8_BAR;
            PG8_LDB(B0, 1, 0); PG8_SCHED; PG8_LDA(At, 1, 0); PG8_STAGE(PG8_SA(0, 1), a2 + hstep, voffA);
            PG8_WAIT_L(8); PG8_BAR; PG8_WAIT_L(0); PG8_MMA(0, 0, At, B0); PG8_BAR; PG8_SCHED;
            PG8_LDB(B1, 1, 1); PG8_STAGE(PG8_SB(1, 0), b3, voffB);
            PG8_BAR; PG8_WAIT_L(0); PG8_MMA(0, 1, At, B1); PG8_BAR;
            PG8_LDA(At, 1, 1); PG8_STAGE(PG8_SA(1, 0), a3, voffA);
            PG8_BAR; PG8_WAIT_L(0); PG8_MMA(1, 0, At, B0); PG8_BAR; PG8_SCHED;
            PG8_STAGE(PG8_SB(1, 1), b3 + hstepB, voffB);
            PG8_WAIT_V(6); PG8_BAR; PG8_MMA(1, 1, At, B1); PG8_BAR;
            }
        }
        if constexpr (ALIGN_EPI) { if (wr == 0) PG8_BAR; }
        if constexpr (!Epi::AFTER_DRAIN) { E(acc, cur, wr, wc, fr, fq); S.done(cur); }
        if (!has_next) break;
#pragma unroll
        for (int a = 0; a < 2; ++a)
#pragma unroll
            for (int b = 0; b < 2; ++b)
#pragma unroll
                for (int m = 0; m < 4; ++m)
#pragma unroll
                    for (int n = 0; n < 2; ++n) acc[a][b][m][n] = (f32x4){0.f, 0.f, 0.f, 0.f};
        cur = nxt; cA = nA; cB = nB; ++ui;
        if constexpr (ALIGN_EPI) { if (wr == 1) PG8_BAR; }
    }
    PG8_WAIT_V(0);
    if constexpr (!ALIGN_EPI) { if (wr == 0) PG8_BAR; }
    PG8_BAR;
    if constexpr (Epi::AFTER_DRAIN) { E.fused(acc, cur, wr, wc, fr, fq, lds, wid, lane); S.done(cur); }
#undef PG8_SA
#undef PG8_SB
#undef PG8_STAGE
#undef PG8_LDA
#undef PG8_LDB
#undef PG8_MMA
#undef PG8_WAIT_V
#undef PG8_WAIT_L
#undef PG8_BAR
#undef PG8_SCHED
}
}

#include <hip/hip_bf16.h>
#include <cmath>
namespace attn_body {
using bf16=__hip_bfloat16;
using bf16x8=__attribute__((ext_vector_type(8)))short;
using s16x4=__attribute__((ext_vector_type(4)))short;
using f32x16=__attribute__((ext_vector_type(16)))float;
using u32x4=__attribute__((ext_vector_type(4)))unsigned;
constexpr int BATCH=32,NHEAD=8,SEQ=2048,D=64,DM=NHEAD*D;
constexpr int NW=8,QBLK=32,QB=QBLK*NW,KVBLK=64,NQB=SEQ/QB;
constexpr int ATTN_PITCH=DM, ATTN_UNIT_ROWS=QB;
__device__ __forceinline__ int crow(int r,int hi){return (r&3)+8*(r>>2)+4*hi;}
#define SBAR() __builtin_amdgcn_sched_barrier(0)
__device__ __forceinline__ void cmask(f32x16&p0,f32x16&p1,int jb,int qrel,int hi){
  const float NEG=-INFINITY; int kb=64*jb+4*hi;
  #pragma unroll
  for(int r=0;r<16;++r){int kv=kb+(r&3)+8*(r>>2); if(kv>qrel)p0[r]=NEG; if(kv+32>qrel)p1[r]=NEG;}
}

constexpr int NSLOT=3, SLOTB=8192;
constexpr int LDS_K=0, LDS_V=NSLOT*SLOTB, LDS_WS=2*NSLOT*SLOTB, LDS_OST=LDS_WS+NW*64*4, LDS_CB=LDS_OST+NW*4096, LDS_BYTES=LDS_CB+SEQ*4;
constexpr float C2=0.125f*1.4426950408889634f;
__device__ __forceinline__ void glds16(const void*gsrc,unsigned lds_dst){unsigned keep;
  asm volatile("s_mov_b32 %0, m0\n\ts_mov_b32 m0, %2\n\ts_nop 0\n\tglobal_load_lds_dwordx4 %1, off\n\ts_mov_b32 m0, %0":"=&s"(keep):"v"(gsrc),"s"(lds_dst):"memory");}
__device__ __forceinline__ float max3f(float a,float b,float c){float r;asm("v_max3_f32 %0, %1, %2, %3":"=v"(r):"v"(a),"v"(b),"v"(c));return r;}
__device__ __forceinline__ float max2f(float a,float b){float r;asm("v_max_f32_e32 %0, %1, %2":"=v"(r):"v"(a),"v"(b));return r;}
__device__ __forceinline__ float fadd_s(float a,float b){float r;asm("v_add_f32_e32 %0, %1, %2":"=v"(r):"v"(a),"v"(b));return r;}
__device__ __forceinline__ float fsub_s(float a,float b){float r;asm("v_sub_f32_e32 %0, %1, %2":"=v"(r):"v"(a),"v"(b));return r;}
typedef float f32x2_t __attribute__((ext_vector_type(2))); typedef __bf16 bf16x2_t __attribute__((ext_vector_type(2)));
__device__ __forceinline__ unsigned cvtpk_s(float lo,float hi){f32x2_t v={lo,hi};bf16x2_t b=__builtin_convertvector(v,bf16x2_t);return __builtin_bit_cast(unsigned,b);}
#define WAIT_BAR(N) asm volatile("s_waitcnt vmcnt(" #N ") lgkmcnt(0)\n\ts_barrier":::"memory")

__device__ __forceinline__ void qkt(f32x16&p0,f32x16&p1,const char*Kslot,const bf16x8*qr,int r32,int hi){
  const char*kb=Kslot+hi*1024+r32*16;
  #pragma unroll
  for(int d0=0;d0<4;++d0){
    const bf16x8 b0=*reinterpret_cast<const bf16x8*>(kb+d0*2048);
    const bf16x8 b1=*reinterpret_cast<const bf16x8*>(kb+d0*2048+512);
    {p0=__builtin_amdgcn_mfma_f32_32x32x16_bf16(b0,qr[d0],p0,0,0,0);p1=__builtin_amdgcn_mfma_f32_32x32x16_bf16(b1,qr[d0],p1,0,0,0);}}
}
typedef __attribute__((address_space(3))) const char* lds_cptr;
typedef float f32x4_t __attribute__((ext_vector_type(4)));
typedef __attribute__((address_space(3))) const f32x4_t* lds_f4p;
typedef short v4i16_t __attribute__((ext_vector_type(4)));
__device__ __forceinline__ void kload8(bf16x8*kf,lds_cptr kp){
  kf[0]=*(const __attribute__((address_space(3))) bf16x8*)(kp);      kf[1]=*(const __attribute__((address_space(3))) bf16x8*)(kp+512);
  kf[2]=*(const __attribute__((address_space(3))) bf16x8*)(kp+2048); kf[3]=*(const __attribute__((address_space(3))) bf16x8*)(kp+2560);
  kf[4]=*(const __attribute__((address_space(3))) bf16x8*)(kp+4096); kf[5]=*(const __attribute__((address_space(3))) bf16x8*)(kp+4608);
  kf[6]=*(const __attribute__((address_space(3))) bf16x8*)(kp+6144); kf[7]=*(const __attribute__((address_space(3))) bf16x8*)(kp+6656);
}
__device__ __forceinline__ void kload2(bf16x8*kf,lds_cptr kp,int j){ kf[2*j]=*(const __attribute__((address_space(3))) bf16x8*)(kp+j*2048); kf[2*j+1]=*(const __attribute__((address_space(3))) bf16x8*)(kp+j*2048+512); }
__device__ __forceinline__ s16x4 vtr(lds_cptr p){ return __builtin_bit_cast(s16x4,__builtin_amdgcn_ds_read_tr16_b64_v4i16((__attribute__((address_space(3))) v4i16_t*)p)); }
__device__ __forceinline__ float rowmax(const f32x16&p0,const f32x16&p1){
  float a=max3f(p0[0],p0[1],p1[0]),b=max3f(p0[2],p0[3],p1[1]);a=max3f(a,p1[2],p1[3]);
  #pragma unroll
  for(int r=4;r<16;r+=4){a=max3f(a,p0[r],p0[r+1]);b=max3f(b,p0[r+2],p0[r+3]);a=max3f(a,p1[r],p1[r+1]);b=max3f(b,p1[r+2],p1[r+3]);}
  const float m=max2f(a,b);
  auto rr=__builtin_amdgcn_permlane32_swap(__float_as_uint(m),__float_as_uint(m),false,false);
  return max2f(__uint_as_float(rr[0]),__uint_as_float(rr[1]));
}
__device__ __forceinline__ void pv(f32x16*o,int vb,bf16x8 pa0,bf16x8 pa1,bf16x8 pa2,bf16x8 pa3){
  #pragma unroll
  for(int d0=0;d0<2;++d0){s16x4 lo[4],hi[4];
    #pragma unroll
    for(int ks=0;ks<4;++ks){
      asm volatile("ds_read_b64_tr_b16 %0,%1 offset:%c2":"=&v"(lo[ks]):"v"(vb),"i"(d0*4096+ks*1024):"memory");
      asm volatile("ds_read_b64_tr_b16 %0,%1 offset:%c2":"=&v"(hi[ks]):"v"(vb),"i"(d0*4096+ks*1024+512):"memory");}
    asm volatile("s_waitcnt lgkmcnt(0)":::"memory");SBAR();
    #define PK(k) (bf16x8){lo[k][0],lo[k][1],lo[k][2],lo[k][3],hi[k][0],hi[k][1],hi[k][2],hi[k][3]}
    o[d0]=__builtin_amdgcn_mfma_f32_32x32x16_bf16(pa0,PK(0),o[d0],0,0,0);
    o[d0]=__builtin_amdgcn_mfma_f32_32x32x16_bf16(pa1,PK(1),o[d0],0,0,0);
    o[d0]=__builtin_amdgcn_mfma_f32_32x32x16_bf16(pa2,PK(2),o[d0],0,0,0);
    o[d0]=__builtin_amdgcn_mfma_f32_32x32x16_bf16(pa3,PK(3),o[d0],0,0,0);
    #undef PK
  }
}

#ifndef ATTN_STORE16
#define ATTN_STORE16(p,v) (*(u32x4*)(p)=(v))
#endif
template<int THRL> __device__ __forceinline__ void attn_unit(int b,int h,int qb,const bf16*Q,const bf16*__restrict__ K,const bf16*__restrict__ V,bf16*O,const float*cbg,char*shm){
  int tid_l=threadIdx.x; asm volatile("":"+v"(tid_l)); const int tid=tid_l,lane=tid&63,r32=lane&31,hi=lane>>5; const int wid=__builtin_amdgcn_readfirstlane(tid>>6);
  const long rowbase=(long)b*SEQ; const int q0=qb*QB;
  const bf16*Qw=Q+(rowbase+q0+wid*QBLK)*DM+h*D;
  const bf16*Kh=K+rowbase*DM+h*D,*Vh=V+rowbase*DM+h*D;
  const unsigned lds0=(unsigned)(uintptr_t)shm;
  float*wsf=(float*)(shm+LDS_WS)+wid*64;
  const bf16*ksrc=Kh+(long)lane*DM+wid*8;
  const bf16*vsrc=Vh+(long)(16*(wid&3)+(lane>>2))*DM+(wid>>2)*32+(lane&3)*8;
  const unsigned kdst=lds0+LDS_K+wid*1024, vdst=lds0+LDS_V+wid*1024;
  #define DMA_K(t,slot) glds16(ksrc+(long)(t)*KVBLK*DM,(unsigned)__builtin_amdgcn_readfirstlane(kdst+(slot)))
  #define DMA_V(t,slot) glds16(vsrc+(long)(t)*KVBLK*DM,(unsigned)__builtin_amdgcn_readfirstlane(vdst+(slot)))
  const int vb0=(int)(lds0+LDS_V)+((lane>>4)&1)*32+(lane&3)*8+(4*hi+((lane&15)>>2))*64;
  const char*Kbase=shm+LDS_K; bf16x8 kf[8];
  const lds_cptr shm3=(lds_cptr)shm; const lds_cptr kp0=shm3+LDS_K+hi*1024+r32*16; const lds_cptr vp0=shm3+LDS_V+((lane>>4)&1)*32+(lane&3)*8+(4*hi+((lane&15)>>2))*64;
  const int NT=(q0+QB)/KVBLK;
  { const f32x4_t cv_=*reinterpret_cast<const f32x4_t*>(cbg+4*tid); *(__attribute__((address_space(3))) f32x4_t*)((lds_cptr)shm+LDS_CB+16*tid)=cv_; }
  const lds_f4p cb4=(lds_f4p)((lds_cptr)shm+LDS_CB);
  #define BINIT(P0,P1,t) do{ const lds_f4p bp_=cb4+((t)*16+hi); _Pragma("unroll") for(int g_=0;g_<4;++g_){ const f32x4_t b0_=bp_[2*g_], b1_=bp_[2*g_+8]; \
      P0[4*g_]=b0_[0]-mhat; P0[4*g_+1]=b0_[1]-mhat; P0[4*g_+2]=b0_[2]-mhat; P0[4*g_+3]=b0_[3]-mhat; \
      P1[4*g_]=b1_[0]-mhat; P1[4*g_+1]=b1_[1]-mhat; P1[4*g_+2]=b1_[2]-mhat; P1[4*g_+3]=b1_[3]-mhat; } }while(0)
  DMA_K(0,0);DMA_V(0,0);DMA_K(1,SLOTB);
  bf16x8 qr[4];
  #pragma unroll
  for(int d0=0;d0<4;++d0)qr[d0]=*reinterpret_cast<const bf16x8*>(&Qw[(long)r32*DM+d0*16+hi*8]);
  float mhat=0.f,l_reg=0.f;f32x16 o[2];o[0]=f32x16{};o[1]=f32x16{};
  const int qrel=wid*QBLK+r32;
  #define CMASK(P0,P1,t) do{int jb_=(t)-(NT-4); if(jb_>=0)cmask(P0,P1,jb_,qrel,hi);}while(0)
  bool resc=false;
  #define START(P0,P1) do{ const float rm=rowmax(P0,P1); resc=false; \
    { const float dl=rm; mhat=fadd_s(mhat,dl); \
      _Pragma("unroll") for(int r=0;r<16;++r){P0[r]=fsub_s(P0[r],dl);P1[r]=fsub_s(P1[r],dl);} \
      } \
    _Pragma("unroll") for(int r=0;r<16;++r)P0[r]=__builtin_amdgcn_exp2f(P0[r]); }while(0)
  #define RESC() do{ if(resc){ asm volatile("s_waitcnt lgkmcnt(0)":::"memory"); \
      _Pragma("unroll") for(int d_=0;d_<2;++d_) _Pragma("unroll") for(int r=0;r<16;++r)o[d_][r]*=wsf[crow(r,hi)]; } }while(0)
  f32x16 pA0,pA1,pB0,pB1;
  int sl_prev=0,sl_cur=0,sl_next=SLOTB;
  #define ROT() do{sl_prev=sl_cur;sl_cur=sl_next;sl_next=(sl_next==(NSLOT-1)*SLOTB)?0:sl_next+SLOTB;}while(0)
  DMA_K(2,2*SLOTB);
  WAIT_BAR(3);
  BINIT(pA0,pA1,0); qkt(pA0,pA1,Kbase,qr,r32,hi);asm volatile("s_nop 15\n\ts_nop 7":"+v"(pA0),"+v"(pA1));CMASK(pA0,pA1,0);
  START(pA0,pA1);
  _Pragma("unroll") for(int r=0;r<16;++r)pA1[r]=__builtin_amdgcn_exp2f(pA1[r]);
  WAIT_BAR(0);
  DMA_K(3,0);DMA_V(1,SLOTB);
  ROT();
  kload8(kf,kp0+sl_cur);
  WAIT_BAR(2);
  s16x4 vlo[8],vhi[8]; u32x4 pw0,pw1,pw2,pw3;
  #define PKW(P,B) cvtpk_s(P[B],P[B+1])
  #define PAF(k) __builtin_bit_cast(bf16x8,pw##k)
  #define VFR(i) (bf16x8){vlo[i][0],vlo[i][1],vlo[i][2],vlo[i][3],vhi[i][0],vhi[i][1],vhi[i][2],vhi[i][3]}
  #define PIN(x) asm volatile("":"+v"(x))
  #define MX3(a,b,c) __builtin_fmaxf(__builtin_fmaxf((a),(b)),(c))
  #define GAPA(MF,A0,A1,A2,A3,W0,W1,PW) do{ MF; sacc+=A0; sacc+=A1; sacc+=A2; sacc+=A3; PIN(sacc); W0; W1; PIN(PW); SBAR(); }while(0)
  #define EX(v) __builtin_amdgcn_exp2f(v)
  #define GAPB(MF,X,B) do{ MF; X[B]=EX(X[B]); X[B+1]=EX(X[B+1]); X[B+2]=EX(X[B+2]); X[B+3]=EX(X[B+3]); PIN(X); SBAR(); }while(0)
  #define VRD(i) do{ vlo[i]=vtr(vp_+(((i)>>2)*4096+((i)&3)*1024)); vhi[i]=vtr(vp_+(((i)>>2)*4096+((i)&3)*1024+512)); }while(0)
  #define KRD(G,j) do{ if(G){ kload2(kf,kp0+sl_next,j); SBAR(); } }while(0)
  #define STEP(C0,C1,P0,P1,t,GK,GV,GL) do{ BINIT(C0,C1,t); SBAR(); \
    const lds_cptr vp_=vp0+sl_prev; \
    VRD(0); SBAR(); float sacc=(P0[0]+P0[1]); \
    GAPA(C0=__builtin_amdgcn_mfma_f32_32x32x16_bf16(kf[0],qr[0],C0,0,0,0), P0[2],P0[3],P0[4],P0[5],     pw0[0]=PKW(P0,0), pw0[1]=PKW(P0,2), pw0); \
    VRD(4); SBAR(); GAPA(C1=__builtin_amdgcn_mfma_f32_32x32x16_bf16(kf[1],qr[0],C1,0,0,0), P0[6],P0[7],P0[8],P0[9],     pw0[2]=PKW(P0,4), pw0[3]=PKW(P0,6), pw0); \
    VRD(1); SBAR(); GAPA(C0=__builtin_amdgcn_mfma_f32_32x32x16_bf16(kf[2],qr[1],C0,0,0,0),   P0[10],P0[11],P0[12],P0[13], pw1[0]=PKW(P0,8), pw1[1]=PKW(P0,10), pw1); \
    VRD(5); SBAR(); GAPA(C1=__builtin_amdgcn_mfma_f32_32x32x16_bf16(kf[3],qr[1],C1,0,0,0),   P0[14],P0[15],P1[0],P1[1],   pw1[2]=PKW(P0,12),pw1[3]=PKW(P0,14), pw1); \
    VRD(2); SBAR(); GAPA(C0=__builtin_amdgcn_mfma_f32_32x32x16_bf16(kf[4],qr[2],C0,0,0,0),   P1[2],P1[3],P1[4],P1[5],     pw2[0]=PKW(P1,0), pw2[1]=PKW(P1,2), pw2); \
    VRD(6); SBAR(); GAPA(C1=__builtin_amdgcn_mfma_f32_32x32x16_bf16(kf[5],qr[2],C1,0,0,0),   P1[6],P1[7],P1[8],P1[9],     pw2[2]=PKW(P1,4), pw2[3]=PKW(P1,6), pw2); \
    VRD(3); SBAR(); GAPA(C0=__builtin_amdgcn_mfma_f32_32x32x16_bf16(kf[6],qr[3],C0,0,0,0),   P1[10],P1[11],P1[12],P1[13], pw3[0]=PKW(P1,8), pw3[1]=PKW(P1,10), pw3); \
    VRD(7); SBAR(); GAPA(C1=__builtin_amdgcn_mfma_f32_32x32x16_bf16(kf[7],qr[3],C1,0,0,0),   P1[14],P1[15],0.f,0.f,       pw3[2]=PKW(P1,12),pw3[3]=PKW(P1,14), pw3); \
    l_reg+=sacc; \
    if(GK){DMA_K((t)+3,sl_cur);} if(GV){DMA_V((t)+1,sl_next);} \
    CMASK(C0,C1,t); \
    { float a=MX3(C0[0],C0[1],C1[0]),b=MX3(C0[2],C0[3],C1[1]); a=MX3(a,C1[2],C1[3]); \
      _Pragma("unroll") for(int r=4;r<16;r+=4){a=MX3(a,C0[r],C0[r+1]);b=MX3(b,C0[r+2],C0[r+3]);a=MX3(a,C1[r],C1[r+1]);b=MX3(b,C1[r+2],C1[r+3]);} \
      float rm=__builtin_fmaxf(a,b); { auto rr=__builtin_amdgcn_permlane32_swap(__float_as_uint(rm),__float_as_uint(rm),false,false); rm=__builtin_fmaxf(__uint_as_float(rr[0]),__uint_as_float(rr[1])); } \
      resc=false; \
      if(__builtin_expect(__any(rm>(float)THRL),0)){ const float dl=__builtin_fmaxf(rm,0.f); mhat+=dl; \
        _Pragma("unroll") for(int r=0;r<16;++r){C0[r]-=dl;C1[r]-=dl;} \
        const float f=__builtin_amdgcn_exp2f(-dl); l_reg*=f; if(hi==0)wsf[r32]=f; resc=true; } } \
    SBAR(); \
    GAPB(o[0]=__builtin_amdgcn_mfma_f32_32x32x16_bf16(PAF(0),VFR(0),o[0],0,0,0), C0,0); \
    GAPB(o[1]=__builtin_amdgcn_mfma_f32_32x32x16_bf16(PAF(0),VFR(4),o[1],0,0,0), C0,4); \
    KRD(GL,0); GAPB(o[0]=__builtin_amdgcn_mfma_f32_32x32x16_bf16(PAF(1),VFR(1),o[0],0,0,0), C0,8); \
    KRD(GL,1); GAPB(o[1]=__builtin_amdgcn_mfma_f32_32x32x16_bf16(PAF(1),VFR(5),o[1],0,0,0), C0,12); \
    KRD(GL,2); GAPB(o[0]=__builtin_amdgcn_mfma_f32_32x32x16_bf16(PAF(2),VFR(2),o[0],0,0,0), C1,0); \
    KRD(GL,3); GAPB(o[1]=__builtin_amdgcn_mfma_f32_32x32x16_bf16(PAF(2),VFR(6),o[1],0,0,0), C1,4); \
    GAPB(o[0]=__builtin_amdgcn_mfma_f32_32x32x16_bf16(PAF(3),VFR(3),o[0],0,0,0), C1,8); \
    GAPB(o[1]=__builtin_amdgcn_mfma_f32_32x32x16_bf16(PAF(3),VFR(7),o[1],0,0,0), C1,12); \
    }while(0)
  int t=1;
  #undef CMASK
  #define CMASK(P0,P1,t) do{}while(0)
  for(;t+5<NT;t+=2){
    STEP(pB0,pB1,pA0,pA1,t,true,true,true);     WAIT_BAR(2); RESC(); ROT();
    STEP(pA0,pA1,pB0,pB1,t+1,true,true,true);   WAIT_BAR(2); RESC(); ROT();
  }
  #undef CMASK
  #define CMASK(P0,P1,t) do{int jb_=(t)-(NT-4); if(jb_>=0)cmask(P0,P1,jb_,qrel,hi);}while(0)
  #define ENDW(tt) do{ if((tt)+3<NT){WAIT_BAR(2);} else if((tt)+2<NT){WAIT_BAR(1);} else {WAIT_BAR(0);} }while(0)
  for(;t+1<NT;t+=2){
    STEP(pB0,pB1,pA0,pA1,t,(t+3<NT),(t+1<NT),(t+1<NT));       ENDW(t);   RESC(); ROT();
    STEP(pA0,pA1,pB0,pB1,t+1,(t+4<NT),(t+2<NT),(t+2<NT));     ENDW(t+1); RESC(); ROT();
  }
  STEP(pB0,pB1,pA0,pA1,NT-1,false,false,false); RESC();
  { float sacc=pB0[0]+pB0[1]; _Pragma("unroll") for(int r=2;r<16;++r)sacc+=pB0[r]; _Pragma("unroll") for(int r=0;r<16;++r)sacc+=pB1[r]; l_reg+=sacc;
    pw0=(u32x4){PKW(pB0,0),PKW(pB0,2),PKW(pB0,4),PKW(pB0,6)};pw1=(u32x4){PKW(pB0,8),PKW(pB0,10),PKW(pB0,12),PKW(pB0,14)};pw2=(u32x4){PKW(pB1,0),PKW(pB1,2),PKW(pB1,4),PKW(pB1,6)};pw3=(u32x4){PKW(pB1,8),PKW(pB1,10),PKW(pB1,12),PKW(pB1,14)};
    SBAR(); pv(o,vb0+sl_cur,PAF(0),PAF(1),PAF(2),PAF(3)); }
  #undef PKW
  #undef PAF
  #undef VFR
  #undef PIN
  #undef MX3
  #undef GAPA
  #undef GAPB
  #undef EX
  #undef VRD
  #undef KRD
  #undef STEP
  #undef ENDW
  {auto rr=__builtin_amdgcn_permlane32_swap(__float_as_uint(l_reg),__float_as_uint(l_reg),false,false);l_reg=__uint_as_float(rr[0])+__uint_as_float(rr[1]);}
  if(hi==0)wsf[32+r32]=l_reg;asm volatile("s_waitcnt lgkmcnt(0)":::"memory");
  float rli[16];
  #pragma unroll
  for(int r=0;r<16;++r)rli[r]=__builtin_amdgcn_rcpf(wsf[32+crow(r,hi)]);
  bf16*Ow=O+(rowbase+q0+wid*QBLK)*DM+h*D;
  { bf16*stg=(bf16*)(shm+LDS_OST)+wid*2048;
    #pragma unroll
    for(int r=0;r<16;++r){const int orow=crow(r,hi);
      #pragma unroll
      for(int d0=0;d0<2;++d0)stg[orow*64+d0*32+r32]=__float2bfloat16(o[d0][r]*rli[r]);}
    asm volatile("s_waitcnt lgkmcnt(0)":::"memory");
    #pragma unroll
    for(int i=0;i<4;++i){const int row=i*8+(lane>>3),ch=lane&7; const u32x4 v=*(const u32x4*)(stg+row*64+ch*8); ATTN_STORE16(Ow+(long)row*DM+ch*8,v);} }
  asm volatile("s_waitcnt lgkmcnt(0)\n\ts_barrier":::"memory");
  #undef BINIT
  #undef DMA_K
  #undef DMA_V
  #undef CMASK
  #undef START
  #undef RESC
  #undef ROT
}
constexpr int ATTN_LDS_BYTES=LDS_BYTES;
#undef SBAR
#undef WAIT_BAR
}

#define LAS __attribute__((address_space(3)))
typedef unsigned short bf16;
typedef unsigned v4u __attribute__((ext_vector_type(4)));
typedef unsigned v2u __attribute__((ext_vector_type(2)));
typedef float f32x4 __attribute__((ext_vector_type(4)));
typedef short bf16x8 __attribute__((ext_vector_type(8)));
__device__ __forceinline__ unsigned f2bf(float f) { unsigned u = __builtin_bit_cast(unsigned, f); return (u + 0x7fffu + ((u >> 16) & 1u)) >> 16; }
__device__ __forceinline__ unsigned pk2(float lo, float hi) { return f2bf(lo) | (f2bf(hi) << 16); }
__device__ __forceinline__ float bf2f(unsigned b) { return __uint_as_float(b << 16); }
__device__ __forceinline__ float wave_sum(float v) {
#pragma unroll
    for (int o = 1; o < 64; o <<= 1) v += __shfl_xor(v, o);
    return v;
}
__device__ __forceinline__ float wave_max(float v) {
#pragma unroll
    for (int o = 1; o < 64; o <<= 1) v = fmaxf(v, __shfl_xor(v, o));
    return v;
}
__device__ __forceinline__ float sigm(float z) { return __builtin_amdgcn_rcpf(1.0f + __builtin_amdgcn_exp2f(-1.4426950408889634f * z)); }

constexpr size_t MiB = 1u << 20;
constexpr size_t WS_BAR = 0, WS_SS = 1 * MiB, WS_CB = 3 * MiB, WS_W = 8 * MiB, WS_WL = 24 * MiB, WS_XB = 64 * MiB, WS_ACT = 200 * MiB;
constexpr size_t SLOT = (size_t)M_ * 512 * 2;
constexpr size_t WS_END = WS_ACT + 8 * SLOT;
constexpr int LDS_BYTES = 147456;
constexpr int NPHASE = 15;
#ifndef PHMASK
#define PHMASK 0x3ff
#endif
#define PK(j) (((PHMASK) >> (j)) & 1)

constexpr size_t O_Y = 0, O_KP = 67633152, O_VP = 134742016, O_LFP = 201850880, O_HP = 202899456, O_CP = 202932224,
                 O_KS = 203030528, O_VS = 203554816, O_LFS = 204079104, O_HS = 204087296, O_CS = 204120064, O_END = 204218368;

struct Args { const float* in[25]; float* out; unsigned char* ws; int ph_lo, ph_hi; };

template <int MODE>
__device__ __forceinline__ void transpose_item(const float* W, int K, int Nsrc, const float* gain, const float* gain2, bf16* WT, LAS float* scr, int kb, int nb, int lane) {
    const int k0 = 64 * kb, n0 = 32 * nb;
    int sc = n0 + (lane & 31);
    if (MODE == 1) { const int r = sc; sc = r < 1536 ? r : (r < 2560 ? r + 8 : (r < 2568 ? r - 1024 : -1)); }
#pragma unroll 8
    for (int i = 0; i < 32; ++i) { const int kk = 2 * i + (lane >> 5); const int k = k0 + kk;
        float gsc = 1.f; if (gain) gsc = (gain2 && k >= 512) ? gain2[k - 512] : gain[k];
        scr[kk * 33 + (lane & 31)] = sc >= 0 ? W[(size_t)k * Nsrc + sc] * gsc : 0.f; }
    asm volatile("s_waitcnt lgkmcnt(0)" ::: "memory");
    const int c = lane & 7;
#pragma unroll
    for (int j = 0; j < 4; ++j) { const int n = (lane >> 3) + 8 * j; const LAS float* s = scr + (8 * c) * 33 + n;
        v4u o; o.x = pk2(s[0 * 33], s[1 * 33]); o.y = pk2(s[2 * 33], s[3 * 33]); o.z = pk2(s[4 * 33], s[5 * 33]); o.w = pk2(s[6 * 33], s[7 * 33]);
        *(v4u*)(WT + (size_t)(n0 + n) * K + k0 + 8 * c) = o; }
    asm volatile("s_waitcnt lgkmcnt(0)" ::: "memory");
}

#define XB_TMO      128
#define XB_XCNT(j)  (256  + 64 * (j))
#define XB_XSUB(j)  (1280 + 64 * (j))
#define XB_XGEN(j)  (2304 + 64 * (j))
#define XB_TOP      3328
#define XB_TOPGEN   3392
#define XCD_BAR_WORDS 3456
#define XB_SPIN_CAP (1u << 18)

__device__ __forceinline__ unsigned xb_ld(unsigned* p)              { return __hip_atomic_load(p, __ATOMIC_RELAXED, __HIP_MEMORY_SCOPE_AGENT); }
__device__ __forceinline__ unsigned xb_add(unsigned* p, unsigned v) { return __hip_atomic_fetch_add(p, v, __ATOMIC_RELAXED, __HIP_MEMORY_SCOPE_AGENT); }
__device__ __forceinline__ unsigned xb_xcc_id() { return (unsigned)__builtin_amdgcn_s_getreg((3 << 11) | 20) & 0xFu; }
#define XB_SPIN(cond, bar) do { unsigned _sp = 0; while (cond) { __builtin_amdgcn_s_sleep(1); \
    if ((++_sp & 255u) == 0u) { if (xb_ld(&(bar)[XB_TMO])) break; if (_sp > XB_SPIN_CAP) { atomicAdd(&(bar)[XB_TMO], 1u); break; } } } } while (0)

struct XcdBarrier {
    unsigned* bar; unsigned x;
    volatile LAS unsigned* st;
};

__device__ __forceinline__ XcdBarrier xcd_barrier_post(unsigned* bar, volatile LAS unsigned* st) {
    XcdBarrier b; b.bar = bar; b.x = xb_xcc_id(); b.st = st;
    if (threadIdx.x == 0) (void)xb_add(&bar[XB_XCNT(b.x)], 1u);
    return b;
}
__device__ __forceinline__ void xcd_barrier_complete(unsigned* bar, unsigned x, unsigned& nloc, unsigned& nx) {
    const unsigned G = gridDim.x * gridDim.y * gridDim.z;
    unsigned sum, cnt, mine, sp = 0u;
    for (;;) {
        sum = 0u; cnt = 0u; mine = 0u;
#pragma unroll
        for (unsigned j = 0; j < 16; ++j) { const unsigned c = xb_ld(&bar[XB_XCNT(j)]); sum += c; cnt += (c > 0u) ? 1u : 0u; mine = (j == x) ? c : mine; }
        if (sum == G) break;
        __builtin_amdgcn_s_sleep(1);
        if ((++sp & 255u) == 0u) { if (xb_ld(&bar[XB_TMO])) break; if (sp > XB_SPIN_CAP) { atomicAdd(&bar[XB_TMO], 1u); break; } }
    }
    nloc = mine > 0u ? mine : 1u; nx = cnt > 0u ? cnt : 1u;
}

__device__ __forceinline__ void xcd_barrier(const XcdBarrier& b) {
    asm volatile("s_waitcnt vmcnt(0)" ::: "memory");
    __syncthreads();
    if (threadIdx.x == 0) {
        unsigned* bar = b.bar;
        __builtin_amdgcn_s_waitcnt(0);
        unsigned nloc = b.st[0], nx = b.st[1];
        if (nloc == 0u) { xcd_barrier_complete(bar, b.x, nloc, nx); b.st[0] = nloc; b.st[1] = nx; }
        const unsigned old = xb_add(&bar[XB_XSUB(b.x)], 1u);
        const unsigned gen = old / nloc;
        if (old + 1u == (gen + 1u) * nloc) {
            __builtin_amdgcn_fence(__ATOMIC_RELEASE, "agent");
            asm volatile("s_waitcnt vmcnt(0)" ::: "memory");
            const unsigned og = xb_add(&bar[XB_TOP], 1u);
            const unsigned tg = og / nx;
            if (og + 1u == (tg + 1u) * nx) xb_add(&bar[XB_TOPGEN], 1u);
            else XB_SPIN(xb_ld(&bar[XB_TOPGEN]) == tg, bar);
            __builtin_amdgcn_fence(__ATOMIC_ACQUIRE, "agent");
            xb_add(&bar[XB_XGEN(b.x)], 1u);
            asm volatile("s_waitcnt vmcnt(0)" ::: "memory");
        } else {
            XB_SPIN(xb_ld(&bar[XB_XGEN(b.x)]) == gen, bar);
            __builtin_amdgcn_fence(__ATOMIC_ACQUIRE, "agent");
            asm volatile("s_waitcnt vmcnt(0)" ::: "memory");
        }
    }
    __syncthreads();
}

struct LayerP {
    const float *conv_w, *conv_b, *wga, *bga, *wgx, *bgx, *lam, *state_h, *state_conv;
    const bf16 *XR, *YG; bf16* LRUO; const bf16 *KB, *VB; float *kout, *vout;
    float *h_p, *conv_p, *h_s, *conv_s;
};

__device__ __forceinline__ unsigned cvt1bf(float v) { unsigned r; asm volatile("v_cvt_pk_bf16_f32 %0, %1, %1" : "=v"(r) : "v"(v)); return r; }
__device__ __forceinline__ void lru_unit(LAS unsigned char* lds, const int tid, const LayerP& P, const int b, const int n, const bool samp) {
    LAS bf16* WT = (LAS bf16*)(lds);
    LAS float* xrS = (LAS float*)(lds + 18432);
    LAS float* xcS = (LAS float*)(lds + 35584);
    LAS bf16* xcB = (LAS bf16*)(lds + 51968);
    LAS float* aS = (LAS float*)(lds + 61184);
    LAS float* bS = (LAS float*)(lds + 77568);
    LAS float* sgA = (LAS float*)(lds + 93952);
    LAS float* sgB = (LAS float*)(lds + 96000);
    LAS float* hS = (LAS float*)(lds + 98048);
    LAS bf16* ygS = (LAS bf16*)(lds + 98304);
    LAS bf16* outS = (LAS bf16*)(lds + 106496);
    const int lane = tid & 63, w = tid >> 6;
    const int Tn = samp ? DT_ : T_; const int R0 = samp ? MP_ + b * DT_ : b * T_; const int ch0 = n * 64;
    for (int e = tid; e < 8192; e += 512) { const int c = e >> 7, j = e & 127;
        const float v = (j < 64) ? P.wga[(size_t)(ch0 + c) * 64 + j] : P.wgx[(size_t)(ch0 + c) * 64 + (j - 64)];
        WT[j * 72 + c] = (bf16)cvt1bf(v); }
    if (tid < 64) hS[tid] = samp ? P.state_h[b * 512 + ch0 + tid] : 0.f;
    const float cw0 = P.conv_w[0 * 512 + ch0 + lane], cw1 = P.conv_w[1 * 512 + ch0 + lane], cw2 = P.conv_w[2 * 512 + ch0 + lane], cw3 = P.conv_w[3 * 512 + ch0 + lane], cbb = P.conv_b[ch0 + lane];
    const int jt = w & 3, th = w >> 2, cm = 16 * jt + (lane & 15);
    const float ba = P.bga[ch0 + cm], bx = P.bgx[ch0 + cm];
    const float sp8 = 8.0f * LOG2E_ * log1pf(__expf(-P.lam[ch0 + cm]));
    __syncthreads();
    bf16x8 Ba[2], Bx[2];
#pragma unroll
    for (int ks = 0; ks < 2; ++ks) {
        Ba[ks] = *(const LAS bf16x8*)(WT + (16 * jt + (lane & 15)) * 72 + 32 * ks + 8 * (lane >> 4));
        Bx[ks] = *(const LAS bf16x8*)(WT + (64 + 16 * jt + (lane & 15)) * 72 + 32 * ks + 8 * (lane >> 4));
    }
    const int vr = tid >> 3, c8 = (tid & 7) * 8;
    const bf16* xrp = P.XR + (size_t)R0 * 512 + ch0 + c8; const bf16* ygp = P.YG + (size_t)R0 * 512 + ch0 + c8; bf16* lop = P.LRUO + (size_t)R0 * 512 + ch0 + c8;
    v4u xq, xq2, yq, kq, vq;
    const bf16* kbp = P.KB + (size_t)R0 * 512 + ch0 + c8; const bf16* vbp = P.VB + (size_t)R0 * 512 + ch0 + c8;
    float* kop = P.kout + (size_t)R0 * 512 + ch0 + c8; float* vop = P.vout + (size_t)R0 * 512 + ch0 + c8;
#define LRU_LOADX(T0) do { const int tau = (T0) + vr - 3; const v4u z_ = {0u, 0u, 0u, 0u}; \
        xq = (tau >= 0 && tau < Tn) ? *(const v4u*)(xrp + (size_t)tau * 512) : z_; \
        xq2 = (tid < 24 && tau + 64 < Tn) ? *(const v4u*)(xrp + (size_t)(tau + 64) * 512) : z_; \
        yq = ((T0) + vr < Tn) ? *(const v4u*)(ygp + (size_t)((T0) + vr) * 512) : z_; \
        if (!samp) { kq = *(const v4u*)(kbp + (size_t)((T0) + vr) * 512); vq = *(const v4u*)(vbp + (size_t)((T0) + vr) * 512); } else { kq = z_; vq = z_; } } while (0)
    LRU_LOADX(0);
    for (int t0 = 0; t0 < Tn; t0 += 64) {
        const int nvalid = (Tn - t0) < 64 ? (Tn - t0) : 64;
        { f32x4 lo_, hi_; lo_[0] = bf2f(xq[0] & 0xffffu); lo_[1] = bf2f(xq[0] >> 16); lo_[2] = bf2f(xq[1] & 0xffffu); lo_[3] = bf2f(xq[1] >> 16);
          hi_[0] = bf2f(xq[2] & 0xffffu); hi_[1] = bf2f(xq[2] >> 16); hi_[2] = bf2f(xq[3] & 0xffffu); hi_[3] = bf2f(xq[3] >> 16);
          *(LAS f32x4*)(xrS + vr * 64 + c8) = lo_; *(LAS f32x4*)(xrS + vr * 64 + c8 + 4) = hi_;
          if (tid < 24) { lo_[0] = bf2f(xq2[0] & 0xffffu); lo_[1] = bf2f(xq2[0] >> 16); lo_[2] = bf2f(xq2[1] & 0xffffu); lo_[3] = bf2f(xq2[1] >> 16);
              hi_[0] = bf2f(xq2[2] & 0xffffu); hi_[1] = bf2f(xq2[2] >> 16); hi_[2] = bf2f(xq2[3] & 0xffffu); hi_[3] = bf2f(xq2[3] >> 16);
              *(LAS f32x4*)(xrS + (64 + vr) * 64 + c8) = lo_; *(LAS f32x4*)(xrS + (64 + vr) * 64 + c8 + 4) = hi_; }
          *(LAS v4u*)(ygS + vr * 64 + c8) = yq; }
        if (!samp) {
            f32x4 a0, a1, b0, b1;
            a0[0] = bf2f(kq[0] & 0xffffu); a0[1] = bf2f(kq[0] >> 16); a0[2] = bf2f(kq[1] & 0xffffu); a0[3] = bf2f(kq[1] >> 16); a1[0] = bf2f(kq[2] & 0xffffu); a1[1] = bf2f(kq[2] >> 16); a1[2] = bf2f(kq[3] & 0xffffu); a1[3] = bf2f(kq[3] >> 16);
            b0[0] = bf2f(vq[0] & 0xffffu); b0[1] = bf2f(vq[0] >> 16); b0[2] = bf2f(vq[1] & 0xffffu); b0[3] = bf2f(vq[1] >> 16); b1[0] = bf2f(vq[2] & 0xffffu); b1[1] = bf2f(vq[2] >> 16); b1[2] = bf2f(vq[3] & 0xffffu); b1[3] = bf2f(vq[3] >> 16);
            float* ko_ = kop + (size_t)(t0 + vr) * 512; float* vo_ = vop + (size_t)(t0 + vr) * 512;
            *(f32x4*)ko_ = a0; *(f32x4*)(ko_ + 4) = a1; *(f32x4*)vo_ = b0; *(f32x4*)(vo_ + 4) = b1;
        }
        if (samp && t0 == 0) { __syncthreads(); if (tid < 192) xrS[tid] = P.state_conv[(size_t)(b * 3 + w) * 512 + ch0 + lane]; }
        __syncthreads();
        if (t0 + 64 < Tn) LRU_LOADX(t0 + 64);
#pragma unroll
        for (int i = 0; i < 8; ++i) { const int t = w + 8 * i;
            const float v = cbb + cw0 * xrS[t * 64 + lane] + cw1 * xrS[(t + 1) * 64 + lane] + cw2 * xrS[(t + 2) * 64 + lane] + cw3 * xrS[(t + 3) * 64 + lane];
            xcS[t * 64 + lane] = v; xcB[t * 72 + lane] = (bf16)cvt1bf(v); }
        __syncthreads();
#pragma unroll
        for (int q = 0; q < 2; ++q) { const int tt = 2 * th + q; f32x4 da = {0.f, 0.f, 0.f, 0.f}, dx = {0.f, 0.f, 0.f, 0.f};
#pragma unroll
            for (int ks = 0; ks < 2; ++ks) { const bf16x8 A = *(const LAS bf16x8*)(xcB + (16 * tt + (lane & 15)) * 72 + 32 * ks + 8 * (lane >> 4));
                da = __builtin_amdgcn_mfma_f32_16x16x32_bf16(A, Ba[ks], da, 0, 0, 0); dx = __builtin_amdgcn_mfma_f32_16x16x32_bf16(A, Bx[ks], dx, 0, 0, 0); }
#pragma unroll
            for (int r = 0; r < 4; ++r) { const int t = 16 * tt + 4 * (lane >> 4) + r;
                const float rg = sigm(da[r] + ba), ig = sigm(dx[r] + bx); const float xc = xcS[t * 64 + cm];
                const float a = __builtin_amdgcn_exp2f(-sp8 * rg); const float bb = __builtin_amdgcn_sqrtf(fmaxf(1.0f - a * a, 0.f)) * ig * xc;
                aS[t * 64 + cm] = a; bS[t * 64 + cm] = bb; } }
        __syncthreads();
        float av[8], bv[8]; float Ac = 1.f, Bc = 0.f;
#pragma unroll
        for (int k = 0; k < 8; ++k) { av[k] = aS[(8 * w + k) * 64 + lane]; bv[k] = bS[(8 * w + k) * 64 + lane]; Bc = av[k] * Bc + bv[k]; Ac *= av[k]; }
        sgA[w * 64 + lane] = Ac; sgB[w * 64 + lane] = Bc;
        __syncthreads();
        float h = hS[lane];
        for (int s = 0; s < w; ++s) h = sgA[s * 64 + lane] * h + sgB[s * 64 + lane];
        float hfin = 0.f; const bool owner = ((nvalid - 1) >> 3) == w;
#pragma unroll
        for (int k = 0; k < 8; ++k) { const int t = 8 * w + k; h = av[k] * h + bv[k];
            const float g = bf2f((unsigned)ygS[t * 64 + lane]); outS[t * 64 + lane] = (bf16)cvt1bf(g * h);
            if (k == ((nvalid - 1) & 7)) hfin = h; }
        __syncthreads();
        if (owner) hS[lane] = hfin;
        if (vr < nvalid) *(v4u*)(lop + (size_t)(t0 + vr) * 512) = *(const LAS v4u*)(outS + vr * 64 + c8);
        if (t0 + 64 >= Tn) {
            float* ho = samp ? P.h_s : P.h_p; float* co = samp ? P.conv_s : P.conv_p;
            if (owner) ho[b * 512 + ch0 + lane] = hfin;
            if (tid < 192) co[(size_t)(b * 3 + w) * 512 + ch0 + lane] = xrS[(nvalid + w) * 64 + lane];
        }
    }
    __syncthreads();
#undef LRU_LOADX
}

__device__ __forceinline__ void cumsum_unit(LAS unsigned char* lds, const int tid, const float* lf  , float* cbo) {
    LAS float* wt = (LAS float*)lds;
    const int lane = tid & 63, w = tid >> 6;
    float v[4];
#pragma unroll
    for (int i = 0; i < 4; ++i) v[i] = lf[(size_t)(4 * tid + i) * 8];
    const float s = (v[0] + v[1]) + (v[2] + v[3]); float inc = s;
#pragma unroll
    for (int o = 1; o < 64; o <<= 1) { const float y = __shfl_up(inc, o); if (lane >= o) inc += y; }
    if (lane == 63) wt[w] = inc;
    __syncthreads();
    float off = 0.f; for (int i = 0; i < w; ++i) off += wt[i];
    float c = off + inc - s; f32x4 o;
#pragma unroll
    for (int i = 0; i < 4; ++i) { c += v[i]; o[i] = -c * LOG2E_; }
    *(f32x4*)(cbo + 4 * tid) = o;
    __syncthreads();
}

struct SampP { const bf16* Q; bf16* O; const float *ck, *cv, *clf, *ks, *vs, *lfs; };
__device__ __forceinline__ void sattn_unit(LAS unsigned char* lds, const int tid, const SampP& P, const int b, const int h) {
    constexpr int NK = PAST_ + DT_, SP = 1064;
    LAS float* cbs = (LAS float*)(lds);
    LAS float* S = (LAS float*)(lds + 4352);
    LAS float* red = (LAS float*)(lds + 72448);
    LAS float* wt = (LAS float*)(lds + 105216);
    const int lane = tid & 63, w = tid >> 6, l15 = lane & 15, l4 = lane >> 4;
    {
        float v[3];
#pragma unroll
        for (int i = 0; i < 3; ++i) { const int j = 3 * tid + i; v[i] = 0.f;
            if (j < PAST_) v[i] = P.clf[((size_t)b * PAST_ + j) * 8 + h]; else if (j < NK) v[i] = P.lfs[((size_t)b * DT_ + (j - PAST_)) * 8 + h]; }
        const float s = v[0] + v[1] + v[2]; float inc = s;
#pragma unroll
        for (int o = 1; o < 64; o <<= 1) { const float y = __shfl_up(inc, o); if (lane >= o) inc += y; }
        if (lane == 63) wt[w] = inc;
        __syncthreads();
        float off = 0.f; for (int i = 0; i < w; ++i) off += wt[i];
        float c = off + inc - s;
#pragma unroll
        for (int i = 0; i < 3; ++i) { const int j = 3 * tid + i; c += v[i]; if (j < NK) cbs[j] = -c * LOG2E_; }
    }
    __syncthreads();
    {
        const bf16* qrow = P.Q + (size_t)(MP_ + b * DT_ + l15) * 512 + h * 64;
        bf16x8 Qf[2];
#pragma unroll
        for (int ks = 0; ks < 2; ++ks) Qf[ks] = *(const bf16x8*)(qrow + 32 * ks + 8 * l4);
        for (int g = w; g < NK / 16; g += 8) {
            const int key = 16 * g + l15;
            const float* kp = key < PAST_ ? P.ck + (((size_t)b * PAST_ + key) * 8 + h) * 64 : P.ks + ((size_t)(b * DT_ + key - PAST_) * 512 + h * 64);
            f32x4 d = {0.f, 0.f, 0.f, 0.f};
#pragma unroll
            for (int ks = 0; ks < 2; ++ks) { const f32x4 k0 = *(const f32x4*)(kp + 32 * ks + 8 * l4), k1 = *(const f32x4*)(kp + 32 * ks + 8 * l4 + 4);
                v4u pk; pk.x = pk2(k0[0], k0[1]); pk.y = pk2(k0[2], k0[3]); pk.z = pk2(k1[0], k1[1]); pk.w = pk2(k1[2], k1[3]);
                d = __builtin_amdgcn_mfma_f32_16x16x32_bf16(Qf[ks], __builtin_bit_cast(bf16x8, pk), d, 0, 0, 0); }
            const float cbk = cbs[key];
#pragma unroll
            for (int r = 0; r < 4; ++r) { const int q = 4 * l4 + r; float s = d[r] + cbk; if (key - PAST_ > q) s = -INFINITY; S[q * SP + key] = s; }
        }
    }
    __syncthreads();
#pragma unroll
    for (int qq = 0; qq < 2; ++qq) { const int q = 2 * w + qq; float m = -INFINITY;
        for (int j = lane; j < NK; j += 64) m = fmaxf(m, S[q * SP + j]);
        m = wave_max(m); float sum = 0.f;
        for (int j = lane; j < NK; j += 64) { const float p = __builtin_amdgcn_exp2f(S[q * SP + j] - m); S[q * SP + j] = p; sum += p; }
        if (lane < 16) S[q * SP + NK + lane] = 0.f;
        sum = wave_sum(sum); if (lane == 0) wt[16 + q] = sum; }
    __syncthreads();
    {
        f32x4 acc[4];
#pragma unroll
        for (int dt = 0; dt < 4; ++dt) acc[dt] = (f32x4){0.f, 0.f, 0.f, 0.f};
        for (int ch = w; ch < 33; ch += 8) {
            const int key0 = 32 * ch + 8 * l4;
            const f32x4 p0 = *(const LAS f32x4*)(S + l15 * SP + key0), p1 = *(const LAS f32x4*)(S + l15 * SP + key0 + 4);
            v4u pp; pp.x = pk2(p0[0], p0[1]); pp.y = pk2(p0[2], p0[3]); pp.z = pk2(p1[0], p1[1]); pp.w = pk2(p1[2], p1[3]);
            const bf16x8 Pf = __builtin_bit_cast(bf16x8, pp);
            float vv[4][8];
#pragma unroll
            for (int jj = 0; jj < 8; ++jj) { int key = key0 + jj; key = key < NK ? key : NK - 1;
                const float* vp = key < PAST_ ? P.cv + (((size_t)b * PAST_ + key) * 8 + h) * 64 : P.vs + ((size_t)(b * DT_ + key - PAST_) * 512 + h * 64);
#pragma unroll
                for (int dt = 0; dt < 4; ++dt) vv[dt][jj] = vp[16 * dt + l15]; }
#pragma unroll
            for (int dt = 0; dt < 4; ++dt) { v4u pv_; pv_.x = pk2(vv[dt][0], vv[dt][1]); pv_.y = pk2(vv[dt][2], vv[dt][3]); pv_.z = pk2(vv[dt][4], vv[dt][5]); pv_.w = pk2(vv[dt][6], vv[dt][7]);
                acc[dt] = __builtin_amdgcn_mfma_f32_16x16x32_bf16(Pf, __builtin_bit_cast(bf16x8, pv_), acc[dt], 0, 0, 0); }
        }
#pragma unroll
        for (int dt = 0; dt < 4; ++dt)
#pragma unroll
            for (int r = 0; r < 4; ++r) red[(w * 16 + 4 * l4 + r) * 64 + 16 * dt + l15] = acc[dt][r];
    }
    __syncthreads();
#pragma unroll
    for (int i = 0; i < 2; ++i) { const int e = tid + 512 * i, q = e >> 6, d = e & 63; float s = 0.f;
#pragma unroll
        for (int ww = 0; ww < 8; ++ww) s += red[(ww * 16 + q) * 64 + d];
        s *= __builtin_amdgcn_rcpf(wt[16 + q]);
        P.O[(size_t)(MP_ + b * DT_ + q) * 512 + h * 64 + d] = (bf16)f2bf(s); }
    __syncthreads();
}

typedef const __attribute__((address_space(4))) Args* ArgsK;
#define PH_BEGIN() ArgsK A = ap; asm volatile("" : "+s"(A)); int tid = threadIdx.x; asm volatile("" : "+v"(tid)); \
    const int lane = tid & 63, wave = __builtin_amdgcn_readfirstlane(tid >> 6); (void)lane; (void)wave; \
    unsigned char* ws = A->ws; float* out = A->out; (void)out; \
    float* ssb = (float*)(ws + WS_SS); float* cbp = (float*)(ws + WS_CB); bf16* XB = (bf16*)(ws + WS_XB); (void)ssb; (void)cbp; (void)XB; \
    bf16* QO = (bf16*)(ws + WS_ACT); bf16* KB = (bf16*)(ws + WS_ACT + SLOT); bf16* VB = (bf16*)(ws + WS_ACT + 2 * SLOT); bf16* XRB = (bf16*)(ws + WS_ACT + 3 * SLOT); \
    bf16* YGB = (bf16*)(ws + WS_ACT + 4 * SLOT); bf16* LRUO = (bf16*)(ws + WS_ACT + 5 * SLOT); bf16* MIX = (bf16*)(ws + WS_ACT + 6 * SLOT); bf16* HB = (bf16*)(ws + WS_ACT); \
    (void)QO; (void)KB; (void)VB; (void)XRB; (void)YGB; (void)LRUO; (void)MIX; (void)HB; \
    const int gw = bid * 8 + wave, NGW = G * 8; (void)gw; (void)NGW;
#define LAYER_PTRS() bf16* wl = (bf16*)(ws + WS_W + (size_t)l * WS_WL); \
const bf16* win_t = wl; const bf16* wout_t = (const bf16*)((unsigned char*)wl + 6 * MiB); const bf16* wup_t = (const bf16*)((unsigned char*)wl + 8 * MiB); const bf16* wdn_t = (const bf16*)((unsigned char*)wl + 16 * MiB); \
float* kp = out + O_KP + (size_t)l * MP_ * 512; float* vp = out + O_VP + (size_t)l * MP_ * 512; float* lfp = out + O_LFP + (size_t)l * MP_ * 8; \
float* ksm = out + O_KS + (size_t)l * MS_ * 512; float* vsm = out + O_VS + (size_t)l * MS_ * 512; float* lfs = out + O_LFS + (size_t)l * MS_ * 8; \
    (void)win_t; (void)wout_t; (void)wup_t; (void)wdn_t; (void)kp; (void)vp; (void)lfp; (void)ksm; (void)vsm; (void)lfs;
__global__ void __launch_bounds__(512, 2) hymba_fwd(Args args_unused) {
    extern __shared__ __attribute__((aligned(16))) unsigned char lds_raw[];
    cg::grid_group grid = cg::this_grid();
    LAS unsigned char* lds = (LAS unsigned char*)lds_raw;
    const ArgsK ap = (ArgsK)__builtin_amdgcn_kernarg_segment_ptr();
    const int G = gridDim.x, bid = blockIdx.x;
    const int lo = ap->ph_lo, hi = ap->ph_hi;
    volatile LAS unsigned* xst = (volatile LAS unsigned*)(lds + 131072 + 64);
    if (threadIdx.x == 0) { xst[0] = 0u; xst[1] = 0u; }
    __syncthreads();
    XcdBarrier bar; bar.bar = (unsigned*)(ap->ws + WS_BAR); bar.x = 0; bar.st = xst;
#define IN(k) (lo <= (k) && (k) < hi)
#define SEAM(k) do { if (IN(k) && IN((k) + 1)) xcd_barrier(bar); } while (0)

#ifndef PROBE_P0N
#define PROBE_P0N 1
#endif
    if (PK(0) && IN(0)) for (int rep_ = 0; rep_ < PROBE_P0N; ++rep_) {
        PH_BEGIN();
        if (bid == 0) for (int i_ = tid; i_ < XCD_BAR_WORDS; i_ += 512) ((unsigned*)(ws + WS_BAR))[i_] = 0u;
        LAS float* scr = (LAS float*)(lds + wave * 16384);
        constexpr int I_IN = 16 * 88, I_OUT = 16 * 32, I_UP = 16 * 128, I_DN = 64 * 32, I_L = I_IN + I_OUT + I_UP + I_DN;
        for (int it = gw; it < 2 * I_L; it += NGW) {
            const int l = it / I_L; int r = it % I_L;
            bf16* wl = (bf16*)(ws + WS_W + (size_t)l * WS_WL);
            if (r < I_IN) { transpose_item<1>(A->in[8] + (size_t)l * 1024 * INW_, 1024, INW_, A->in[7] + l * 1024, nullptr, wl, scr, r / 88, r % 88, lane); continue; } r -= I_IN;
            if (r < I_OUT) { transpose_item<0>(A->in[21] + (size_t)l * 1024 * 1024, 1024, 1024, A->in[19] + l * 512, A->in[20] + l * 512, (bf16*)((unsigned char*)wl + 6 * MiB), scr, r / 32, r % 32, lane); continue; } r -= I_OUT;
            if (r < I_UP) { transpose_item<0>(A->in[23] + (size_t)l * 1024 * 4096, 1024, 4096, A->in[22] + l * 1024, nullptr, (bf16*)((unsigned char*)wl + 8 * MiB), scr, r / 128, r % 128, lane); continue; } r -= I_UP;
            transpose_item<0>(A->in[24] + (size_t)l * 4096 * 1024, 4096, 1024, nullptr, nullptr, (bf16*)((unsigned char*)wl + 16 * MiB), scr, r / 32, r % 32, lane);
        }
        for (int m0 = gw * 4; m0 < M_; m0 += NGW * 4) {
            f32x4 v[4][4];
#pragma unroll
            for (int r = 0; r < 4; ++r) { const int m = m0 + r; const float* xr = m < MP_ ? A->in[0] + (size_t)m * 1024 : A->in[1] + (size_t)(m - MP_) * 1024;
#pragma unroll
                for (int j = 0; j < 4; ++j) v[r][j] = *(const f32x4*)(xr + 256 * j + 4 * lane); }
#pragma unroll
            for (int r = 0; r < 4; ++r) { const int m = m0 + r; float s = 0.f;
#pragma unroll
                for (int j = 0; j < 4; ++j) s += (v[r][j][0] * v[r][j][0] + v[r][j][1] * v[r][j][1]) + (v[r][j][2] * v[r][j][2] + v[r][j][3] * v[r][j][3]);
                s = wave_sum(s);
#pragma unroll
                for (int j = 0; j < 4; ++j) { v2u o; o.x = pk2(v[r][j][0], v[r][j][1]); o.y = pk2(v[r][j][2], v[r][j][3]); *(v2u*)(XB + (size_t)m * 1024 + 256 * j + 4 * lane) = o; }
                if (lane == 0) { ssb[m] = s; ssb[M_ + m] = 0.f; ssb[2 * M_ + m] = 0.f; ssb[3 * M_ + m] = 0.f; } }
        }
    }
    if (IN(0) && IN(1)) { grid.sync(); bar = xcd_barrier_post((unsigned*)(ap->ws + WS_BAR), xst); xcd_barrier(bar); }
#ifdef PROBE_SYNC
    for (int i_ = 0; i_ < 8; ++i_) grid.sync();
#endif

#pragma unroll 1
    for (int l = 0; l < DEPTH_; ++l) {
        const int pb = 1 + 7 * l;
        if (PK(1) && IN(pb)) {
            PH_BEGIN(); LAYER_PTRS();
            if (l == 1) {
                for (int m = MP_ + gw; m < M_; m += NGW) { const float* xr = out + (size_t)m * 1024; f32x4 v[4]; float s = 0.f;
#pragma unroll
                    for (int j = 0; j < 4; ++j) { v[j] = *(const f32x4*)(xr + 256 * j + 4 * lane); s += (v[j][0] * v[j][0] + v[j][1] * v[j][1]) + (v[j][2] * v[j][2] + v[j][3] * v[j][3]); }
                    s = wave_sum(s);
#pragma unroll
                    for (int j = 0; j < 4; ++j) { v2u o; o.x = pk2(v[j][0], v[j][1]); o.y = pk2(v[j][2], v[j][3]); *(v2u*)(XB + (size_t)m * 1024 + 256 * j + 4 * lane) = o; }
                    if (lane == 0) ssb[M_ + m] = s; }
                xcd_barrier(bar);
            }
            pg8::Gemm g{XB, win_t, M_, NIN_, 1024, 1024}; pg8::StaticOrder S; S.init(M_, NIN_, G, bid);
            pg8::EpiIn E{QO, out, SLOT / 2, l, ssb + (size_t)l * M_, A->in[10] + l * 64, A->in[11] + l * 64, A->in[9] + l * 8};
            pg8::gemm_phase<pg8::EpiIn, pg8::StaticOrder, true, true, true>(lds, g, S, E);
#ifdef PROBE_IN2
            pg8::gemm_phase<pg8::EpiIn, pg8::StaticOrder, true, true, true>(lds, g, S, E);
#endif
        }
        SEAM(pb);

        if (PK(2) && IN(pb + 1)) {
            PH_BEGIN(); LAYER_PTRS();
            LayerP P;
            P.conv_w = A->in[12] + l * 2048; P.conv_b = A->in[13] + l * 512; P.wga = A->in[14] + (size_t)l * 32768; P.bga = A->in[15] + l * 512;
            P.wgx = A->in[16] + (size_t)l * 32768; P.bgx = A->in[17] + l * 512; P.lam = A->in[18] + l * 512;
            P.state_h = A->in[5] + (size_t)l * DB_ * 512; P.state_conv = A->in[6] + (size_t)l * DB_ * 3 * 512;
            P.XR = XRB; P.YG = YGB; P.LRUO = LRUO; P.KB = KB; P.VB = VB; P.kout = kp; P.vout = vp;
            P.h_p = out + O_HP + (size_t)l * NB_ * 512; P.conv_p = out + O_CP + (size_t)l * NB_ * 3 * 512; P.h_s = out + O_HS + (size_t)l * DB_ * 512; P.conv_s = out + O_CS + (size_t)l * DB_ * 3 * 512;
            for (int u = bid; u < 256; u += G) lru_unit(lds, tid, P, u >> 3, u & 7, false);
#ifdef PROBE_LRU
            for (int u = bid; u < 256; u += G) lru_unit(lds, tid, P, u >> 3, u & 7, false);
#endif
            for (int u = bid; u < 256; u += G) lru_unit(lds, tid, P, u >> 3, u & 7, true);
            for (int u = bid; u < 256; u += G) cumsum_unit(lds, tid, lfp + (size_t)(u >> 3) * T_ * 8 + (u & 7), cbp + (size_t)u * T_);
        }
        SEAM(pb + 1);

        if (PK(3) && IN(pb + 2)) {
            PH_BEGIN(); LAYER_PTRS();
#ifdef PROBE_ATTN
            for (int u = bid; u < 256; u += G) {
#pragma unroll 1
                for (int qb = 7; qb >= 0; --qb)
                    attn_body::attn_unit<64>(u >> 3, u & 7, qb, (const attn_body::bf16*)QO, (const attn_body::bf16*)KB, (const attn_body::bf16*)VB, (attn_body::bf16*)MIX, cbp + (size_t)u * T_, (char*)lds_raw);
            }
#endif
            if (PK(8)) for (int u = bid; u < 256; u += G) {
#pragma unroll 1
                for (int qb = 7; qb >= 0; --qb)
                    attn_body::attn_unit<64>(u >> 3, u & 7, qb, (const attn_body::bf16*)QO, (const attn_body::bf16*)KB, (const attn_body::bf16*)VB, (attn_body::bf16*)QO, cbp + (size_t)u * T_, (char*)lds_raw);
            }
            SampP SPp{QO, QO, A->in[2] + (size_t)l * DB_ * PAST_ * 512, A->in[3] + (size_t)l * DB_ * PAST_ * 512, A->in[4] + (size_t)l * DB_ * PAST_ * 8, ksm, vsm, lfs};
#ifdef PROBE_SATTN
            { SampP SPq = SPp; SPq.O = MIX; for (int u = bid; u < 256; u += G) sattn_unit(lds, tid, SPq, u >> 3, u & 7); }
#endif
            if (PK(9)) for (int u = bid; u < 256; u += G) sattn_unit(lds, tid, SPp, u >> 3, u & 7);
        }
        SEAM(pb + 2);

        if (PK(4) && IN(pb + 3)) {
            PH_BEGIN(); LAYER_PTRS();
            for (int m0 = gw * 4; m0 < M_; m0 += NGW * 4) {
                v4u a[4], c[4];
#pragma unroll
                for (int r = 0; r < 4; ++r) { a[r] = *(const v4u*)(QO + (size_t)(m0 + r) * 512 + 8 * lane); c[r] = *(const v4u*)(LRUO + (size_t)(m0 + r) * 512 + 8 * lane); }
#pragma unroll
                for (int r = 0; r < 4; ++r) { const int m = m0 + r;
                    float fa[8], fc[8]; float sa = 0.f, sc = 0.f;
#pragma unroll
                    for (int j = 0; j < 4; ++j) { fa[2 * j] = bf2f(a[r][j] & 0xffffu); fa[2 * j + 1] = bf2f(a[r][j] >> 16); fc[2 * j] = bf2f(c[r][j] & 0xffffu); fc[2 * j + 1] = bf2f(c[r][j] >> 16); }
#pragma unroll
                    for (int j = 0; j < 8; ++j) { sa += fa[j] * fa[j]; sc += fc[j] * fc[j]; }
                    sa = wave_sum(sa); sc = wave_sum(sc);
                    const float ra = 1.0f / sqrtf(sa * (1.0f / 512.0f) + EPS_), rc = 1.0f / sqrtf(sc * (1.0f / 512.0f) + EPS_);
                    v4u oa, oc;
#pragma unroll
                    for (int j = 0; j < 4; ++j) { oa[j] = pk2(fa[2 * j] * ra, fa[2 * j + 1] * ra); oc[j] = pk2(fc[2 * j] * rc, fc[2 * j + 1] * rc); }
                    *(v4u*)(MIX + (size_t)m * 1024 + 8 * lane) = oa; *(v4u*)(MIX + (size_t)m * 1024 + 512 + 8 * lane) = oc; }
            }
        }
        SEAM(pb + 3);

        if (PK(5) && IN(pb + 4)) {
            PH_BEGIN(); LAYER_PTRS();
            pg8::Gemm g{MIX, wout_t, M_, 1024, 1024, 1024}; pg8::StaticOrder S; S.init(M_, 1024, G, bid);
            pg8::EpiRes E{l == 0 ? A->in[0] : out, l == 0 ? A->in[1] : out + (size_t)MP_ * 1024, out, XB, ssb + (size_t)(2 + l) * M_, 1};
            pg8::gemm_phase<pg8::EpiRes, pg8::StaticOrder, true, true, false>(lds, g, S, E);
        }
        SEAM(pb + 4);

        if (PK(6) && IN(pb + 5)) {
            PH_BEGIN(); LAYER_PTRS();
            pg8::Gemm g{XB, wup_t, M_, FF_, 1024, 1024}; pg8::StaticOrder S; S.init(M_, FF_, G, bid);
            pg8::EpiUp E{HB, ssb + (size_t)(2 + l) * M_};
            pg8::gemm_phase<pg8::EpiUp, pg8::StaticOrder, true, true, false>(lds, g, S, E);
#ifdef PROBE_UP2
            pg8::gemm_phase<pg8::EpiUp, pg8::StaticOrder, true, true, false>(lds, g, S, E);
#endif
        }
        SEAM(pb + 5);

        if (PK(7) && IN(pb + 6)) {
            PH_BEGIN(); LAYER_PTRS();
            pg8::Gemm g{HB, wdn_t, MP_, 1024, FF_, FF_}; pg8::StaticOrder S; S.init(MP_, 1024, G, bid);
            pg8::EpiRes E{out, out + (size_t)MP_ * 1024, out, XB, ssb + (size_t)M_, l == 0 ? 1 : 0};
            pg8::gemm_phase<pg8::EpiRes, pg8::StaticOrder, true, true, false>(lds, g, S, E);
            pg8::Gemm g2{HB, wdn_t, M_, 1024, 1024, FF_}; pg8::SampSplitOrder S2{bid};
            pg8::EpiAtomic E2{out};
            pg8::gemm_phase<pg8::EpiAtomic, pg8::SampSplitOrder, true, true, false>(lds, g2, S2, E2);
        }
        SEAM(pb + 6);
    }
#undef IN
#undef SEAM
}

extern "C" void kernel_launch(void* const* d_in, const int* in_sizes, int n_in, void* d_out, int out_size, void* d_ws, size_t ws_size, hipStream_t stream) {
    static int grid = 0;
    if (grid == 0) {
        if (n_in != 25 || (size_t)out_size != O_END || ws_size < WS_END) { fprintf(stderr, "kernel_launch: unexpected problem (n_in %d out %d ws %zu need %zu)\n", n_in, out_size, ws_size, (size_t)WS_END); grid = -1; return; }
        int dev = 0, cus = 0, per_cu = 0;
        hipGetDevice(&dev); hipDeviceGetAttribute(&cus, hipDeviceAttributeMultiprocessorCount, dev);
        if (hipFuncSetAttribute((const void*)hymba_fwd, hipFuncAttributeMaxDynamicSharedMemorySize, LDS_BYTES) != hipSuccess) { fprintf(stderr, "kernel_launch: hipFuncSetAttribute failed\n"); (void)hipGetLastError(); }
        if (hipOccupancyMaxActiveBlocksPerMultiprocessor(&per_cu, (const void*)hymba_fwd, 512, LDS_BYTES) != hipSuccess || per_cu < 1) { fprintf(stderr, "kernel_launch: occupancy query says %d\n", per_cu); per_cu = 1; (void)hipGetLastError(); }
        grid = cus * per_cu;
        fprintf(stderr, "kernel_launch: grid %d (cus %d x %d)\n", grid, cus, per_cu);
    }
    if (grid < 0) return;
    Args a{};
    for (int i = 0; i < 25; ++i) a.in[i] = (const float*)d_in[i];
    a.out = (float*)d_out; a.ws = (unsigned char*)d_ws; a.ph_lo = 0; a.ph_hi = NPHASE;
    void* kargs[] = {&a};
    hipError_t e = hipLaunchCooperativeKernel((const void*)hymba_fwd, dim3(grid), dim3(512), kargs, LDS_BYTES, stream);
    if (e != hipSuccess) fprintf(stderr, "kernel_launch: cooperative launch failed: %s (grid %d)\n", hipGetErrorString(e), grid);
}
```
